# Optimizing an MI355X kernel written in HIP

```python
import math
import jax
import jax.numpy as jnp
from jax import lax
import numpy as np

D_MODEL = 1024
BATCH = 16
SEQ = 2048
DEPTH = 2

GRID_W = 64
CTX_LEN = 256
Q_BLOCK = 128
ROPE_THETA = 10000.0
EPS = 1e-6
N_MOD = 6

DIFF_HEADS = 4
DIFF_HEAD_DIM = 64
DIFF_V_DIM = 2 * DIFF_HEAD_DIM
GQA_Q_HEADS = 8
GQA_KV_HEADS = 2
GQA_GROUP = GQA_Q_HEADS // GQA_KV_HEADS
GQA_HEAD_DIM = 64
MLA_HEADS = 8
MLA_Q_LORA = 384
MLA_KV_LORA = 256
MLA_NOPE_DIM = 64
MLA_ROPE_DIM = 32
MLA_QK_DIM = MLA_NOPE_DIM + MLA_ROPE_DIM
MLA_V_DIM = 64

N_BRANCHES = 3
DIFF_WIDTH = DIFF_HEADS * DIFF_V_DIM
GQA_WIDTH = GQA_Q_HEADS * GQA_HEAD_DIM
MLA_WIDTH = MLA_HEADS * MLA_V_DIM
FFN_HIDDEN = -((-8 * D_MODEL) // (3 * 256)) * 256

IN_SIZES = (
    DIFF_HEADS * 2 * DIFF_HEAD_DIM,
    DIFF_HEADS * 2 * DIFF_HEAD_DIM,
    DIFF_WIDTH,
    GQA_Q_HEADS * GQA_HEAD_DIM,
    GQA_KV_HEADS * GQA_HEAD_DIM,
    GQA_KV_HEADS * GQA_HEAD_DIM,
    MLA_Q_LORA,
    MLA_KV_LORA,
    MLA_ROPE_DIM,
    N_BRANCHES * D_MODEL,
)
IN_WIDTH = sum(IN_SIZES)
IN_SPLITS = [sum(IN_SIZES[:i + 1]) for i in range(len(IN_SIZES) - 1)]

kernel_name = 'hybrid_diff_gqa_mla_prefix_dit_block'


def _rmsnorm(x, g):
    xf = x.astype(jnp.float32)
    y = xf * lax.rsqrt(jnp.mean(xf * xf, axis=-1, keepdims=True) + EPS)
    return (y * g.astype(jnp.float32)).astype(x.dtype)


def _modulate(h, shift, scale):
    return h * (1.0 + scale) + shift


def _rope_angles(row, col, dim):
    a = dim // 2
    freqs = ROPE_THETA ** (-jnp.arange(0, a, 2, dtype=jnp.float32) / a)
    return (row.astype(jnp.float32)[:, None] * freqs, col.astype(jnp.float32)[:, None] * freqs)


def _rope1d(x, ang):
    ang = ang.reshape(ang.shape[:1] + (1,) * (x.ndim - 3) + ang.shape[1:])
    cos, sin = jnp.cos(ang), jnp.sin(ang)
    x1, x2 = jnp.split(x.astype(jnp.float32), 2, axis=-1)
    return jnp.concatenate([x1 * cos - x2 * sin, x1 * sin + x2 * cos], axis=-1).astype(x.dtype)


def _rope2d(x, angs):
    ang_row, ang_col = angs
    a = x.shape[-1] // 2
    return jnp.concatenate([_rope1d(x[..., :a], ang_row), _rope1d(x[..., a:], ang_col)], axis=-1)


def _sweep_queries(fn, q):
    B, L = q.shape[:2]
    nb = L // Q_BLOCK
    qb = jnp.moveaxis(q.reshape((B, nb, Q_BLOCK) + q.shape[2:]), 1, 0)
    out = jnp.moveaxis(lax.map(fn, qb), 0, 1)
    return out.reshape((B, L) + out.shape[3:])


def _diff_attn_block(q, k, v, lam):
    s = jnp.einsum('bqhmd,bkhmd->bhmqk', q, k).astype(jnp.float32) * (DIFF_HEAD_DIM ** -0.5)
    p = jax.nn.softmax(s, axis=-1)
    w = (p[:, :, 0] - lam * p[:, :, 1]).astype(v.dtype)
    return jnp.einsum('bhqk,bkhe->bqhe', w, v)


def _gqa_block(q, k, v, scale):
    s = jnp.einsum('bqhgd,bkhd->bhgqk', q, k).astype(jnp.float32) * scale
    p = jax.nn.softmax(s, axis=-1).astype(v.dtype)
    return jnp.einsum('bhgqk,bkhe->bqhge', p, v)


def _branch_inputs(h, angs, p):
    B, L = h.shape[:2]
    z = h @ p['w_in']
    dq, dk, dv, gq, gk, gv, mcq, mckv, mkr, gt = jnp.split(z, IN_SPLITS, axis=-1)
    dq = dq.reshape(B, L, DIFF_HEADS, 2, DIFF_HEAD_DIM)
    dk = dk.reshape(B, L, DIFF_HEADS, 2, DIFF_HEAD_DIM)
    dv = dv.reshape(B, L, DIFF_HEADS, DIFF_V_DIM)
    gq = _rmsnorm(gq.reshape(B, L, GQA_KV_HEADS, GQA_GROUP, GQA_HEAD_DIM), p['g_gqa_q'])
    gk = _rmsnorm(gk.reshape(B, L, GQA_KV_HEADS, GQA_HEAD_DIM), p['g_gqa_k'])
    gv = gv.reshape(B, L, GQA_KV_HEADS, GQA_HEAD_DIM)
    mq = (_rmsnorm(mcq, p['g_mla_q']) @ p['w_mla_uq']).reshape(B, L, MLA_HEADS, MLA_QK_DIM)
    mkv = (_rmsnorm(mckv, p['g_mla_kv']) @ p['w_mla_ukv']).reshape(B, L, MLA_HEADS, MLA_NOPE_DIM + MLA_V_DIM)
    mq_nope, mq_rope = jnp.split(mq, [MLA_NOPE_DIM], axis=-1)
    mk_nope, mv = jnp.split(mkv, [MLA_NOPE_DIM], axis=-1)
    if angs is not None:
        angs_qk, angs_mla = angs
        dq = _rope2d(dq, angs_qk)
        dk = _rope2d(dk, angs_qk)
        gq = _rope2d(gq, angs_qk)
        gk = _rope2d(gk, angs_qk)
        mq_rope = _rope2d(mq_rope, angs_mla)
        mkr = _rope2d(mkr, angs_mla)
    mq = jnp.concatenate([mq_nope, mq_rope], axis=-1)[:, :, :, None, :]
    mk = jnp.concatenate(
        [mk_nope, jnp.broadcast_to(mkr[:, :, None, :], (B, L, MLA_HEADS, MLA_ROPE_DIM))], axis=-1)
    return (dq, gq, mq), (dk, dv, gk, gv, mk, mv), gt


def _mix_branches(queries, keys, gates_pre, lam, lam_init, p):
    dq, gq, mq = queries
    dk, dv, gk, gv, mk, mv = keys
    B, L = dq.shape[:2]
    o_diff = _sweep_queries(lambda qb: _diff_attn_block(qb, dk, dv, lam), dq)
    o_diff = _rmsnorm(o_diff, p['g_diff_out']) * (1.0 - lam_init)
    o_gqa = _sweep_queries(lambda qb: _gqa_block(qb, gk, gv, GQA_HEAD_DIM ** -0.5), gq)
    o_mla = _sweep_queries(lambda qb: _gqa_block(qb, mk, mv, MLA_QK_DIM ** -0.5), mq)
    gate = jax.nn.sigmoid((gates_pre + p['b_gate']).astype(jnp.float32)).astype(gates_pre.dtype)
    gate = gate.reshape(B, L, N_BRANCHES, D_MODEL)
    y = (gate[:, :, 0] * (o_diff.reshape(B, L, DIFF_WIDTH) @ p['w_br_diff'])
         + gate[:, :, 1] * (o_gqa.reshape(B, L, GQA_WIDTH) @ p['w_br_gqa'])
         + gate[:, :, 2] * (o_mla.reshape(B, L, MLA_WIDTH) @ p['w_br_mla']))
    return y @ p['w_out']


def _swiglu(h, w_in, w_out):
    g, u = jnp.split(h @ w_in, 2, axis=-1)
    return (jax.nn.silu(g) * u) @ w_out


def _lambda_init(layer):
    return 0.8 - 0.6 * math.exp(-0.3 * layer)


def setup_inputs(seed: int = 0) -> dict:
    key = jax.random.key(seed)
    ks = jax.random.split(key, 28)
    f32 = jnp.float32

    def nrm(k, shape):
        return jax.random.normal(k, shape, f32)

    return {
        'x': nrm(ks[0], (BATCH, SEQ, D_MODEL)),
        'c': nrm(ks[1], (BATCH, D_MODEL)),
        'ctx': nrm(ks[2], (BATCH, CTX_LEN, D_MODEL)),
        'c_ctx': nrm(ks[3], (D_MODEL,)),
        'w_mod': nrm(ks[4], (DEPTH, D_MODEL, N_MOD * D_MODEL)) * (0.5 * D_MODEL ** -0.5),
        'b_mod': 0.02 * nrm(ks[5], (DEPTH, N_MOD * D_MODEL)),
        'g_norm1': 1.0 + 0.02 * nrm(ks[6], (DEPTH, D_MODEL)),
        'w_in': nrm(ks[7], (DEPTH, D_MODEL, IN_WIDTH)) * D_MODEL ** -0.5,
        'b_gate': 0.02 * nrm(ks[8], (DEPTH, N_BRANCHES * D_MODEL)),
        'lam_q1': 0.1 * nrm(ks[9], (DEPTH, DIFF_HEAD_DIM)),
        'lam_k1': 0.1 * nrm(ks[10], (DEPTH, DIFF_HEAD_DIM)),
        'lam_q2': 0.1 * nrm(ks[11], (DEPTH, DIFF_HEAD_DIM)),
        'lam_k2': 0.1 * nrm(ks[12], (DEPTH, DIFF_HEAD_DIM)),
        'g_diff_out': 1.0 + 0.02 * nrm(ks[13], (DEPTH, DIFF_V_DIM)),
        'g_gqa_q': 1.0 + 0.02 * nrm(ks[14], (DEPTH, GQA_HEAD_DIM)),
        'g_gqa_k': 1.0 + 0.02 * nrm(ks[15], (DEPTH, GQA_HEAD_DIM)),
        'g_mla_q': 1.0 + 0.02 * nrm(ks[16], (DEPTH, MLA_Q_LORA)),
        'w_mla_uq': nrm(ks[17], (DEPTH, MLA_Q_LORA, MLA_HEADS * MLA_QK_DIM)) * MLA_Q_LORA ** -0.5,
        'g_mla_kv': 1.0 + 0.02 * nrm(ks[18], (DEPTH, MLA_KV_LORA)),
        'w_mla_ukv': nrm(ks[19], (DEPTH, MLA_KV_LORA, MLA_HEADS * (MLA_NOPE_DIM + MLA_V_DIM))) * MLA_KV_LORA ** -0.5,
        'w_br_diff': nrm(ks[20], (DEPTH, DIFF_WIDTH, D_MODEL)) * DIFF_WIDTH ** -0.5,
        'w_br_gqa': nrm(ks[21], (DEPTH, GQA_WIDTH, D_MODEL)) * GQA_WIDTH ** -0.5,
        'w_br_mla': nrm(ks[22], (DEPTH, MLA_WIDTH, D_MODEL)) * MLA_WIDTH ** -0.5,
        'w_out': nrm(ks[23], (DEPTH, D_MODEL, D_MODEL)) * D_MODEL ** -0.5,
        'g_norm2': 1.0 + 0.02 * nrm(ks[24], (DEPTH, D_MODEL)),
        'w_ffn_in': nrm(ks[25], (DEPTH, D_MODEL, 2 * FFN_HIDDEN)) * D_MODEL ** -0.5,
        'w_ffn_out': nrm(ks[26], (DEPTH, FFN_HIDDEN, D_MODEL)) * FFN_HIDDEN ** -0.5,
        'g_final': 1.0 + 0.02 * nrm(ks[27], (D_MODEL,)),
    }


def reference(x, c, ctx, c_ctx, w_mod, b_mod, g_norm1, w_in, b_gate, lam_q1, lam_k1, lam_q2, lam_k2,
              g_diff_out, g_gqa_q, g_gqa_k, g_mla_q, w_mla_uq, g_mla_kv, w_mla_ukv,
              w_br_diff, w_br_gqa, w_br_mla, w_out, g_norm2, w_ffn_in, w_ffn_out, g_final):
    f32 = jnp.float32
    L = x.shape[1]
    rows = L // GRID_W
    row = jnp.repeat(jnp.arange(rows, dtype=jnp.int32), GRID_W)
    col = jnp.tile(jnp.arange(GRID_W, dtype=jnp.int32), rows)
    angs_qk = _rope_angles(row, col, DIFF_HEAD_DIM)
    angs_mla = _rope_angles(row, col, MLA_ROPE_DIM)
    xc = ctx
    for l in range(DEPTH):
        p = {
            'w_in': w_in[l], 'b_gate': b_gate[l], 'g_diff_out': g_diff_out[l],
            'g_gqa_q': g_gqa_q[l], 'g_gqa_k': g_gqa_k[l],
            'g_mla_q': g_mla_q[l], 'w_mla_uq': w_mla_uq[l], 'g_mla_kv': g_mla_kv[l], 'w_mla_ukv': w_mla_ukv[l],
            'w_br_diff': w_br_diff[l], 'w_br_gqa': w_br_gqa[l], 'w_br_mla': w_br_mla[l], 'w_out': w_out[l],
        }
        lam_init = _lambda_init(l)
        lam = (jnp.exp(jnp.sum(lam_q1[l].astype(f32) * lam_k1[l].astype(f32)))
               - jnp.exp(jnp.sum(lam_q2[l].astype(f32) * lam_k2[l].astype(f32))) + lam_init)
        mod = jnp.split((jax.nn.silu(c) @ w_mod[l] + b_mod[l])[:, None, :], N_MOD, axis=-1)
        mod_c = jnp.split((jax.nn.silu(c_ctx) @ w_mod[l] + b_mod[l])[None, None, :], N_MOD, axis=-1)
        h = _modulate(_rmsnorm(x, g_norm1[l]), mod[0], mod[1])
        hc = _modulate(_rmsnorm(xc, g_norm1[l]), mod_c[0], mod_c[1])
        q_lat, k_lat, gt_lat = _branch_inputs(h, (angs_qk, angs_mla), p)
        q_ctx, k_ctx, gt_ctx = _branch_inputs(hc, None, p)
        k_all = tuple(jnp.concatenate([kc, kl], axis=1) for kc, kl in zip(k_ctx, k_lat))
        x = x + mod[2] * _mix_branches(q_lat, k_all, gt_lat, lam, lam_init, p)
        x = x + mod[5] * _swiglu(_modulate(_rmsnorm(x, g_norm2[l]), mod[3], mod[4]), w_ffn_in[l], w_ffn_out[l])
        if l < DEPTH - 1:
            xc = xc + mod_c[2] * _mix_branches(q_ctx, k_ctx, gt_ctx, lam, lam_init, p)
            xc = xc + mod_c[5] * _swiglu(_modulate(_rmsnorm(xc, g_norm2[l]), mod_c[3], mod_c[4]),
                                         w_ffn_in[l], w_ffn_out[l])
    return _rmsnorm(x, g_final)
```

```cpp
#include <hip/hip_runtime.h>
#include <hip/hip_cooperative_groups.h>
#include <cstdio>
#include <cstdint>
namespace cg = cooperative_groups;

#define LAS __attribute__((address_space(3)))
typedef unsigned short bf16_t;
typedef short bf16x8 __attribute__((ext_vector_type(8)));
typedef short s16x4 __attribute__((ext_vector_type(4)));
typedef float f32x2 __attribute__((ext_vector_type(2)));
typedef float f32x4 __attribute__((ext_vector_type(4)));
typedef float f32x16 __attribute__((ext_vector_type(16)));
typedef unsigned u32x2 __attribute__((ext_vector_type(2)));
typedef unsigned u32x4 __attribute__((ext_vector_type(4)));

constexpr int DM = 1024, NB = 16, SEQ = 2048, CTXL = 256, DEPTH = 2;
constexpr int GB = 8;
constexpr int NG = NB / GB;
constexpr int TLG = GB * SEQ;
constexpr int TCG = GB * CTXL;
constexpr int TG = TLG + TCG;
constexpr int ZW = 6144, INW = 6048;
constexpr int C_DQ = 0, C_DK = 512, C_DV = 1024, C_GQ = 1536, C_GK = 2048, C_GV = 2176, C_MCQ = 2304, C_MCKV = 2688, C_MKR = 2944, C_GT = 2976;
constexpr int FH = 2816, NMOD = 6 * DM;
constexpr float EPS = 1e-6f;
constexpr float LOG2E = 1.4426950408889634f;
constexpr float C2_64 = 0.125f * LOG2E;
constexpr float C2_96 = 0.10206207261596575f * LOG2E;
constexpr float L2T = 13.287712379549449f;
constexpr float INV2PI = 0.15915494309189535f;

constexpr size_t MiB = 1u << 20;
constexpr size_t WS_MOD = 1 * MiB;
constexpr size_t WS_RS = 2 * MiB;
constexpr size_t WS_W = 3 * MiB;
constexpr size_t WL_IN = 0, WL_UQ = 12 * MiB, WL_UKV = 13 * MiB, WL_BR = 14 * MiB, WL_OUT = 17 * MiB, WL_F1 = 19 * MiB, WL_F2 = 30 * MiB, WL_SZ = 36 * MiB;
constexpr size_t WS_XC = 75 * MiB;
constexpr size_t WS_XN = 91 * MiB;
constexpr size_t WS_Z = 127 * MiB;
constexpr size_t WS_QM = 343 * MiB;
constexpr size_t WS_KM = 370 * MiB;
constexpr size_t WS_VM = 397 * MiB;
constexpr size_t WS_O3 = 415 * MiB;
constexpr size_t WS_SCR = 469 * MiB;
constexpr size_t WS_WP7 = 501 * MiB;
constexpr size_t WS_WP10 = 503 * MiB;
constexpr size_t WS_WP6 = 509 * MiB;
constexpr size_t WS_END = 512 * MiB;
static_assert(WS_XN + (size_t)TG * 1024 * 2 <= WS_Z && WS_Z + (size_t)TG * ZW * 2 <= WS_QM && WS_QM + (size_t)TG * 768 * 2 <= WS_KM && WS_KM + (size_t)TG * 768 * 2 <= WS_VM &&
              WS_VM + (size_t)TG * 512 * 2 <= WS_O3 && WS_O3 + (size_t)TG * 1536 * 2 <= WS_SCR && WS_SCR + 256 * 131072 <= WS_END, "ws map");

constexpr int LDS_BYTES = 147456;
constexpr int NCU = 256;

__device__ __forceinline__ unsigned cvt_pk_bf16(float lo, float hi) { unsigned r; asm volatile("v_cvt_pk_bf16_f32 %0, %1, %2" : "=v"(r) : "v"(lo), "v"(hi)); return r; }
__device__ __forceinline__ float bf_lo(unsigned w) { return __uint_as_float(w << 16); }
__device__ __forceinline__ float bf_hi(unsigned w) { return __uint_as_float(w & 0xffff0000u); }
__device__ __forceinline__ float bf1(bf16_t v) { return __uint_as_float(((unsigned)v) << 16); }
template <int CTRL> __device__ __forceinline__ float dpp_f(float v) { return __builtin_bit_cast(float, __builtin_amdgcn_update_dpp(0, __builtin_bit_cast(int, v), CTRL, 0xF, 0xF, true)); }
__device__ __forceinline__ float xadd1(float v) { return v + dpp_f<0xB1>(v); }
__device__ __forceinline__ float xadd2(float v) { return v + dpp_f<0x4E>(v); }
__device__ __forceinline__ float row16_sum(float v) { v = xadd1(v); v = xadd2(v); v += dpp_f<0x141>(v); v += dpp_f<0x140>(v); return v; }
__device__ __forceinline__ float half32_sum(float v) { v = row16_sum(v); v += __builtin_bit_cast(float, __builtin_amdgcn_ds_swizzle(__builtin_bit_cast(int, v), 0x401F)); return v; }
__device__ __forceinline__ float wave_sum(float v) {
    v = half32_sum(v);
    auto rr = __builtin_amdgcn_permlane32_swap(__float_as_uint(v), __float_as_uint(v), false, false);
    return __uint_as_float(rr[0]) + __uint_as_float(rr[1]);
}
__device__ __forceinline__ float fast_exp(float x) { return __builtin_amdgcn_exp2f(x * LOG2E); }
__device__ __forceinline__ float sigmoidf(float x) { return __builtin_amdgcn_rcpf(1.f + fast_exp(-x)); }
__device__ __forceinline__ void rope_pair(float& x1, float& x2, float ang) {
    const float rv = ang * INV2PI; const float s = __builtin_amdgcn_sinf(rv), c = __builtin_amdgcn_cosf(rv);
    const float a = x1 * c - x2 * s, b = x1 * s + x2 * c; x1 = a; x2 = b;
}

namespace pg8 {
constexpr int BM = 256, BK = 64, HALF = 128, HTB = HALF * BK * 2, STAGE_BYTES = 8 * HTB, NXCD = 8, WGM = 8;
__host__ __device__ __forceinline__ int lds_byte(int r, int c) { const int st = (r >> 4) * 2 + (c >> 5), rr = r & 15, cc = c & 31, ob = rr * 64 + cc * 2; return st * 1024 + (ob ^ (((ob >> 9) & 1) << 5)); }
__host__ __device__ __forceinline__ void stage_rc(int b, int& R, int& C) { const int st = b / 1024, sb = b % 1024, swz = sb ^ (((sb >> 9) & 1) << 5); R = (st >> 1) * 16 + swz / 64; C = (st & 1) * 32 + (swz % 64) / 2; }
__host__ __device__ __forceinline__ int perm32(int rho) { const int n = rho >> 4, i = rho & 15; return 8 * (i >> 2) + 4 * n + (i & 3); }

struct Unit { int pm, pn, koff; };
struct Gemm { const bf16_t* A; const bf16_t* Bt; int lda; int K; };

struct StaticOrder {
    int nM, nN, nwg, G, c;
    __device__ void init(int M, int N, int G_, int c_) { nM = M / BM; nN = N / BM; nwg = nM * nN; G = G_; c = c_; }
    __device__ bool next(int i, Unit& u) const {
        const long L = (long)i * G + c; if (L >= nwg) return false;
        int wgid = (int)L; { const int q = nwg / NXCD, r = nwg % NXCD, xcd = wgid % NXCD, off = wgid / NXCD; wgid = (xcd < r ? xcd * (q + 1) : r * (q + 1) + (xcd - r) * q) + off; }
        const int nig = WGM * nN, gid = wgid / nig, fm = gid * WGM, gsz = (nM - fm) < WGM ? (nM - fm) : WGM;
        u.pm = fm + ((wgid % nig) % gsz); u.pn = (wgid % nig) / gsz; u.koff = 0; return true;
    }
};

template <int S, int KP>
struct SplitOrder {
    int pm0, nun, G, c;
    __device__ void init(int pm0_, int ntiles, int G_, int c_) { pm0 = pm0_; nun = ntiles * 4 * S; G = G_; c = c_; }
    __device__ bool next(int i, Unit& u) const {
        const int j = i * G + c; if (j >= nun) return false;
        const int tile = j / S, part = j % S; u.pm = pm0 + (tile >> 2); u.pn = part * 4 + (tile & 3); u.koff = part * KP * 2; return true;
    }
};
typedef f32x4 Acc[2][2][4][2];

struct EpiBf16 {
    static constexpr bool PERM = true, MIDHOOK = false;
    bf16_t* O; int ldc;
    __device__ __forceinline__ void mid(Acc& acc, const Unit& u, int t, int wr, int wc, int fr, int fq) const {}
    __device__ __forceinline__ void operator()(const Acc& acc, const Unit& u, int wr, int wc, int fr, int fq) const {
        const int row0 = u.pm * BM + wr * 64 + fr, col0 = u.pn * BM + wc * 32 + 8 * fq;
#pragma unroll
        for (int ai = 0; ai < 2; ++ai)
#pragma unroll
            for (int m = 0; m < 4; ++m) { bf16_t* rowp = O + (size_t)(row0 + ai * HALF + m * 16) * ldc + col0;
#pragma unroll
                for (int bj = 0; bj < 2; ++bj) { const f32x4 v0 = acc[ai][bj][m][0], v1 = acc[ai][bj][m][1];
                    u32x4 w; w.x = cvt_pk_bf16(v0[0], v0[1]); w.y = cvt_pk_bf16(v0[2], v0[3]); w.z = cvt_pk_bf16(v1[0], v1[1]); w.w = cvt_pk_bf16(v1[2], v1[3]);
                    *(u32x4*)(rowp + bj * HALF) = w; } }
    }
};
struct EpiMlaQ {
    static constexpr bool PERM = true, MIDHOOK = false;
    bf16_t* O; const float* rs;
    __device__ __forceinline__ void mid(Acc& acc, const Unit& u, int t, int wr, int wc, int fr, int fq) const {}
    __device__ __forceinline__ void operator()(const Acc& acc, const Unit& u, int wr, int wc, int fr, int fq) const {
        const int row0 = u.pm * BM + wr * 64 + fr, col0 = u.pn * BM + wc * 32 + 8 * fq;
        float rsv[2][4];
#pragma unroll
        for (int ai = 0; ai < 2; ++ai)
#pragma unroll
            for (int m = 0; m < 4; ++m) rsv[ai][m] = rs[2 * (row0 + ai * HALF + m * 16)];
#pragma unroll
        for (int ai = 0; ai < 2; ++ai)
#pragma unroll
            for (int m = 0; m < 4; ++m) { const int row = row0 + ai * HALF + m * 16; const float sc = rsv[ai][m];
                const int tk = row & (SEQ - 1); const bool lat = row < TLG;
                const float prow = lat ? (float)(tk >> 6) : 0.f, pcol = lat ? (float)(tk & 63) : 0.f;
#pragma unroll
                for (int bj = 0; bj < 2; ++bj) { const int c = col0 + bj * HALF; const int off = c % 96;
                    f32x4 v0 = acc[ai][bj][m][0] * sc, v1 = acc[ai][bj][m][1] * sc;
                    if (off >= 64) { const int ib = (off - 64) >> 1; const float pos = ib < 8 ? prow : pcol; const int jb = ib & 7;
                        const float f0 = __builtin_amdgcn_exp2f(-(float)(jb + 0) * (L2T / 8.f)), f1 = __builtin_amdgcn_exp2f(-(float)(jb + 1) * (L2T / 8.f));
                        const float f2 = __builtin_amdgcn_exp2f(-(float)(jb + 2) * (L2T / 8.f)), f3 = __builtin_amdgcn_exp2f(-(float)(jb + 3) * (L2T / 8.f));
                        float a0 = v0[0], a1 = v0[1], a2 = v0[2], a3 = v0[3], b0 = v1[0], b1 = v1[1], b2 = v1[2], b3 = v1[3];
                        rope_pair(a0, a1, pos * f0); rope_pair(a2, a3, pos * f1); rope_pair(b0, b1, pos * f2); rope_pair(b2, b3, pos * f3);
                        v0 = (f32x4){a0, a1, a2, a3}; v1 = (f32x4){b0, b1, b2, b3}; }
                    v0 = v0 * C2_96; v1 = v1 * C2_96;
                    u32x4 w; w.x = cvt_pk_bf16(v0[0], v0[1]); w.y = cvt_pk_bf16(v0[2], v0[3]); w.z = cvt_pk_bf16(v1[0], v1[1]); w.w = cvt_pk_bf16(v1[2], v1[3]);
                    *(u32x4*)(O + (size_t)row * 768 + c) = w; }
                asm volatile("" ::: "memory"); }
    }
};
struct EpiMlaKV {
    static constexpr bool PERM = true, MIDHOOK = false;
    bf16_t* KM; bf16_t* VM; const float* rs;
    __device__ __forceinline__ void mid(Acc& acc, const Unit& u, int t, int wr, int wc, int fr, int fq) const {}
    __device__ __forceinline__ void operator()(const Acc& acc, const Unit& u, int wr, int wc, int fr, int fq) const {
        const int row0 = u.pm * BM + wr * 64 + fr, col0 = u.pn * BM + wc * 32 + 8 * fq;
        float rsv[2][4];
#pragma unroll
        for (int ai = 0; ai < 2; ++ai)
#pragma unroll
            for (int m = 0; m < 4; ++m) rsv[ai][m] = rs[2 * (row0 + ai * HALF + m * 16)];
#pragma unroll
        for (int ai = 0; ai < 2; ++ai)
#pragma unroll
            for (int m = 0; m < 4; ++m) { const int row = row0 + ai * HALF + m * 16; const float sc = rsv[ai][m];
#pragma unroll
                for (int bj = 0; bj < 2; ++bj) { const int c = col0 + bj * HALF;
                    const f32x4 v0 = acc[ai][bj][m][0] * sc, v1 = acc[ai][bj][m][1] * sc;
                    u32x4 w; w.x = cvt_pk_bf16(v0[0], v0[1]); w.y = cvt_pk_bf16(v0[2], v0[3]); w.z = cvt_pk_bf16(v1[0], v1[1]); w.w = cvt_pk_bf16(v1[2], v1[3]);
                    bf16_t* dst = (c < 512) ? KM + (size_t)row * 768 + (c >> 6) * 96 + (c & 63) : VM + (size_t)row * 512 + (c - 512);
                    *(u32x4*)dst = w; }
                asm volatile("" ::: "memory"); }
    }
};
struct EpiGate {
    static constexpr bool PERM = true, MIDHOOK = true;
    const bf16_t* Z; const float* bg; bf16_t* Y;
    __device__ __forceinline__ void mid(Acc& acc, const Unit& u, int t, int wr, int wc, int fr, int fq) const {
        const int bc = (t >> 3) - 1;
        int row0 = u.pm * BM + wr * 64 + fr; const int col0 = u.pn * BM + wc * 32 + 8 * fq;
        asm volatile("" : "+v"(row0));
#pragma unroll
        for (int bj = 0; bj < 2; ++bj) { const float* b0 = bg + bc * 1024 + col0 + bj * HALF;
            const f32x4 bc0 = *(const f32x4*)b0, bc1 = *(const f32x4*)(b0 + 4), bn0 = *(const f32x4*)(b0 + 1024), bn1 = *(const f32x4*)(b0 + 1028);
#pragma unroll
            for (int ai = 0; ai < 2; ++ai) {
            u32x4 gc[4], gn[4];
#pragma unroll
                for (int m = 0; m < 4; ++m) { const unsigned zo = (unsigned)((row0 + ai * HALF + m * 16) * ZW + col0 + bj * HALF) * 2u;
                    const char* zb = (const char*)(Z + C_GT + bc * 1024);
                    gc[m] = *(const u32x4*)(zb + zo); gn[m] = *(const u32x4*)(zb + 2048 + zo); }
            asm volatile("" ::: "memory"); __builtin_amdgcn_sched_barrier(0);
#pragma unroll
                for (int m = 0; m < 4; ++m) { const u32x4 c = gc[m], n = gn[m];
                    const f32x4 xc0 = (f32x4){bf_lo(c.x), bf_hi(c.x), bf_lo(c.y), bf_hi(c.y)} + bc0, xc1 = (f32x4){bf_lo(c.z), bf_hi(c.z), bf_lo(c.w), bf_hi(c.w)} + bc1;
                    const f32x4 xn0 = (f32x4){bf_lo(n.x), bf_hi(n.x), bf_lo(n.y), bf_hi(n.y)} + bn0, xn1 = (f32x4){bf_lo(n.z), bf_hi(n.z), bf_lo(n.w), bf_hi(n.w)} + bn1;
                    f32x4 f0, f1;
#pragma unroll
                    for (int e = 0; e < 4; ++e) { f0[e] = (1.f + fast_exp(-xn0[e])) * __builtin_amdgcn_rcpf(1.f + fast_exp(-xc0[e])); f1[e] = (1.f + fast_exp(-xn1[e])) * __builtin_amdgcn_rcpf(1.f + fast_exp(-xc1[e])); }
                    acc[ai][bj][m][0] *= f0; acc[ai][bj][m][1] *= f1; }
            asm volatile("" ::: "memory"); } }
    }
    __device__ __forceinline__ void operator()(const Acc& acc, const Unit& u, int wr, int wc, int fr, int fq) const {
        const int row0 = u.pm * BM + wr * 64 + fr, col0 = u.pn * BM + wc * 32 + 8 * fq;
#pragma unroll
        for (int bj = 0; bj < 2; ++bj) { const float* b0 = bg + 2 * 1024 + col0 + bj * HALF;
            const f32x4 bb0 = *(const f32x4*)b0, bb1 = *(const f32x4*)(b0 + 4);
#pragma unroll
            for (int ai = 0; ai < 2; ++ai) {
            u32x4 gq[4];
#pragma unroll
                for (int m = 0; m < 4; ++m) gq[m] = *(const u32x4*)(Z + (size_t)(row0 + ai * HALF + m * 16) * ZW + C_GT + 2 * 1024 + col0 + bj * HALF);
            asm volatile("" ::: "memory"); __builtin_amdgcn_sched_barrier(0);
#pragma unroll
                for (int m = 0; m < 4; ++m) { const int row = row0 + ai * HALF + m * 16; const u32x4 gc = gq[m];
                    const f32x4 x0 = (f32x4){bf_lo(gc.x), bf_hi(gc.x), bf_lo(gc.y), bf_hi(gc.y)} + bb0, x1 = (f32x4){bf_lo(gc.z), bf_hi(gc.z), bf_lo(gc.w), bf_hi(gc.w)} + bb1;
                    f32x4 v0 = acc[ai][bj][m][0], v1 = acc[ai][bj][m][1];
#pragma unroll
                    for (int e = 0; e < 4; ++e) { v0[e] *= sigmoidf(x0[e]); v1[e] *= sigmoidf(x1[e]); }
                    u32x4 w; w.x = cvt_pk_bf16(v0[0], v0[1]); w.y = cvt_pk_bf16(v0[2], v0[3]); w.z = cvt_pk_bf16(v1[0], v1[1]); w.w = cvt_pk_bf16(v1[2], v1[3]);
                    *(u32x4*)(Y + (size_t)row * 1024 + col0 + bj * HALF) = w; }
            asm volatile("" ::: "memory"); } }
    }
};
struct EpiResid {
    static constexpr bool PERM = false, MIDHOOK = false;
    float* XL; const float* XR; const float* mod; int g; int moff;
    __device__ __forceinline__ void mid(Acc& acc, const Unit& u, int t, int wr, int wc, int fr, int fq) const {}
    __device__ __forceinline__ void operator()(const Acc& acc, const Unit& u, int wr, int wc, int fr, int fq) const {
        const int col0 = u.pn * BM + wc * 32 + 4 * fq;
        const int r0 = u.pm * BM;
        float* xb = XL + (size_t)r0 * DM; const float* xr = XR + (size_t)r0 * DM; const float* mb = mod + (size_t)(g * GB + (r0 >> 11)) * NMOD + moff;
        f32x4 mv[2][2];
#pragma unroll
        for (int bj = 0; bj < 2; ++bj)
#pragma unroll
            for (int n = 0; n < 2; ++n) mv[bj][n] = *(const f32x4*)(mb + col0 + bj * HALF + n * 16);
#pragma unroll
        for (int ai = 0; ai < 2; ++ai) {
            f32x4 xv[4][2][2];
#pragma unroll
            for (int m = 0; m < 4; ++m)
#pragma unroll
                for (int bj = 0; bj < 2; ++bj)
#pragma unroll
                    for (int n = 0; n < 2; ++n) xv[m][bj][n] = *(const f32x4*)(xr + (unsigned)((ai * HALF + wr * 64 + m * 16 + fr) * DM + col0 + bj * HALF + n * 16));
            asm volatile("" ::: "memory"); __builtin_amdgcn_sched_barrier(0);
#pragma unroll
            for (int m = 0; m < 4; ++m)
#pragma unroll
                for (int bj = 0; bj < 2; ++bj)
#pragma unroll
                    for (int n = 0; n < 2; ++n) *(f32x4*)(xb + (unsigned)((ai * HALF + wr * 64 + m * 16 + fr) * DM + col0 + bj * HALF + n * 16)) = xv[m][bj][n] + mv[bj][n] * acc[ai][bj][m][n];
            asm volatile("" ::: "memory"); }
    }
};
struct EpiGateP {
    static constexpr bool PERM = true, MIDHOOK = false;
    const bf16_t* Z; const float* bg; float* PG;
    __device__ __forceinline__ void mid(Acc& acc, const Unit& u, int t, int wr, int wc, int fr, int fq) const {}
    __device__ __forceinline__ void operator()(const Acc& acc, const Unit& u, int wr, int wc, int fr, int fq) const {
        const int br = u.pn >> 2; const int row0 = u.pm * BM + wr * 64 + fr, col0 = (u.pn & 3) * BM + wc * 32 + 8 * fq;
        float* pb = PG + (size_t)br * TCG * DM;
#pragma unroll
        for (int bj = 0; bj < 2; ++bj) { const float* b0 = bg + br * 1024 + col0 + bj * HALF;
            const f32x4 bb0 = *(const f32x4*)b0, bb1 = *(const f32x4*)(b0 + 4);
#pragma unroll
            for (int ai = 0; ai < 2; ++ai) {
                u32x4 gq[4];
#pragma unroll
                for (int m = 0; m < 4; ++m) gq[m] = *(const u32x4*)(Z + (size_t)(row0 + ai * HALF + m * 16) * ZW + C_GT + br * 1024 + col0 + bj * HALF);
                asm volatile("" ::: "memory");
#pragma unroll
                for (int m = 0; m < 4; ++m) { const int row = row0 + ai * HALF + m * 16; const u32x4 gc = gq[m];
                    const f32x4 x0 = (f32x4){bf_lo(gc.x), bf_hi(gc.x), bf_lo(gc.y), bf_hi(gc.y)} + bb0, x1 = (f32x4){bf_lo(gc.z), bf_hi(gc.z), bf_lo(gc.w), bf_hi(gc.w)} + bb1;
                    f32x4 v0 = acc[ai][bj][m][0], v1 = acc[ai][bj][m][1];
#pragma unroll
                    for (int e = 0; e < 4; ++e) { v0[e] *= sigmoidf(x0[e]); v1[e] *= sigmoidf(x1[e]); }
                    float* dst = pb + (size_t)(row - TLG) * DM + col0 + bj * HALF; *(f32x4*)dst = v0; *(f32x4*)(dst + 4) = v1; }
                asm volatile("" ::: "memory"); } }
    }
};
struct EpiPartial {
    static constexpr bool PERM = false, MIDHOOK = false;
    float* P; const float* mod; int moff;
    __device__ __forceinline__ void mid(Acc& acc, const Unit& u, int t, int wr, int wc, int fr, int fq) const {}
    __device__ __forceinline__ void operator()(const Acc& acc, const Unit& u, int wr, int wc, int fr, int fq) const {
        float* pb = P + ((size_t)(u.pn >> 2) * TCG + (size_t)(u.pm * BM - TLG)) * DM; const float* mb = mod + (size_t)16 * NMOD + moff;
        const int col0 = (u.pn & 3) * BM + wc * 32 + 4 * fq;
#pragma unroll
        for (int bj = 0; bj < 2; ++bj)
#pragma unroll
            for (int n = 0; n < 2; ++n) { const int c = col0 + bj * HALF + n * 16; const f32x4 mv = *(const f32x4*)(mb + c);
#pragma unroll
                for (int ai = 0; ai < 2; ++ai)
#pragma unroll
                    for (int m = 0; m < 4; ++m) *(f32x4*)(pb + (unsigned)((ai * HALF + wr * 64 + m * 16 + fr) * DM + c)) = mv * acc[ai][bj][m][n]; }
    }
};
struct EpiSwiGLU {
    static constexpr bool PERM = true, MIDHOOK = false;
    bf16_t* H;
    __device__ __forceinline__ void mid(Acc& acc, const Unit& u, int t, int wr, int wc, int fr, int fq) const {}
    __device__ __forceinline__ void operator()(const Acc& acc, const Unit& u, int wr, int wc, int fr, int fq) const {
        const int row0 = u.pm * BM + wr * 64 + fr, col0 = u.pn * HALF + wc * 32 + 8 * fq;
#pragma unroll
        for (int ai = 0; ai < 2; ++ai)
#pragma unroll
            for (int m = 0; m < 4; ++m) { const int row = row0 + ai * HALF + m * 16;
                f32x4 v0, v1;
#pragma unroll
                for (int e = 0; e < 4; ++e) { const float g0 = acc[ai][0][m][0][e], g1 = acc[ai][0][m][1][e];
                    v0[e] = g0 * sigmoidf(g0) * acc[ai][1][m][0][e]; v1[e] = g1 * sigmoidf(g1) * acc[ai][1][m][1][e]; }
                u32x4 w; w.x = cvt_pk_bf16(v0[0], v0[1]); w.y = cvt_pk_bf16(v0[2], v0[3]); w.z = cvt_pk_bf16(v1[0], v1[1]); w.w = cvt_pk_bf16(v1[2], v1[3]);
                *(u32x4*)(H + (size_t)row * FH + col0) = w; }
    }
};

template <class Epi, class Sched, bool ALIGN_EPI, bool SP2>
__device__ __forceinline__ void gemm_phase(LAS unsigned char* lds, const Gemm g, const Sched& S, const Epi& E) {
    int tid_ = threadIdx.x; asm volatile("" : "+v"(tid_));
    const int tid = tid_, wid = __builtin_amdgcn_readfirstlane(tid >> 6), lane = tid & 63, wr = wid >> 2, wc = wid & 3, fr = lane & 15, fq = lane >> 4;
    const int K = g.K, nt = K / BK, lda = g.lda;
    unsigned voffA[2], voffB[2];
#pragma unroll
    for (int i = 0; i < 2; ++i) { int R, C; stage_rc(tid * 16 + i * 8192, R, C); const int Rb = Epi::PERM ? ((R & ~31) + perm32(R & 31)) : R;
        voffA[i] = (unsigned)(R * lda + C) * 2u; voffB[i] = (unsigned)(Rb * K + C) * 2u; }
    const size_t kstep = (size_t)(BK * 2);
    const size_t hstepA = (size_t)HALF * lda * 2, hstepB = (size_t)HALF * K * 2;
    const size_t tstepA = 2 * hstepA, tstepB = 2 * hstepB;
    const unsigned ldsw = (unsigned)wid * 1024u;
    const int aoff = lds_byte(wr * 64 + fr, fq * 8), boff = lds_byte(wc * 32 + fr, fq * 8);
#define PG8_SA(b, h) (((b) * 2 + (h)) * HTB)
#define PG8_SB(b, h) ((4 + (b) * 2 + (h)) * HTB)
#define PG8_STAGE(bufoff, gbase, voff) do { _Pragma("unroll") for (int _i = 0; _i < 2; ++_i) \
        __builtin_amdgcn_global_load_lds((const unsigned*)((const char*)(gbase) + (voff)[_i]), (LAS unsigned*)(lds + (bufoff) + ldsw + _i * 8192), 16, 0, 0); } while (0)
#define PG8_LDA(dst, b, h) do { _Pragma("unroll") for (int m = 0; m < 4; ++m) _Pragma("unroll") for (int k = 0; k < 2; ++k) dst[m][k] = *(const LAS bf16x8*)(lds + PG8_SA(b, h) + aoff + m * 2048 + k * 1024); } while (0)
#define PG8_LDB(dst, b, h) do { _Pragma("unroll") for (int n = 0; n < 2; ++n) _Pragma("unroll") for (int k = 0; k < 2; ++k) dst[n][k] = *(const LAS bf16x8*)(lds + PG8_SB(b, h) + boff + n * 2048 + k * 1024); } while (0)
#define PG8_MMA(ai, bj, At, Bt) do { __builtin_amdgcn_s_setprio(1); _Pragma("unroll") for (int m = 0; m < 4; ++m) _Pragma("unroll") for (int n = 0; n < 2; ++n) _Pragma("unroll") for (int k = 0; k < 2; ++k) \
        acc[ai][bj][m][n] = __builtin_amdgcn_mfma_f32_16x16x32_bf16(Bt[n][k], At[m][k], acc[ai][bj][m][n], 0, 0, 0); __builtin_amdgcn_s_setprio(0); } while (0)
#define PG8_WAIT_V(n) asm volatile("s_waitcnt vmcnt(" #n ")" ::: "memory")
#define PG8_WAIT_L(n) asm volatile("s_waitcnt lgkmcnt(" #n ")" ::: "memory")
#define PG8_BAR __builtin_amdgcn_s_barrier()
#define PG8_SCHED __builtin_amdgcn_sched_barrier(0)
    Unit cur, nxt; int ui = 0;
    if (!S.next(0, cur)) return;
    Acc acc;
#pragma unroll
    for (int a = 0; a < 2; ++a)
#pragma unroll
        for (int b = 0; b < 2; ++b)
#pragma unroll
            for (int m = 0; m < 4; ++m)
#pragma unroll
                for (int n = 0; n < 2; ++n) acc[a][b][m][n] = (f32x4){0.f, 0.f, 0.f, 0.f};
    bf16x8 At[4][2], B0[2][2], B1[2][2];
    const char* cA = (const char*)g.A + (size_t)cur.pm * tstepA + cur.koff; const char* cB = (const char*)g.Bt + (size_t)cur.pn * tstepB;
    static_assert(SP2, "only the SP2 loop is kept");
    PG8_STAGE(PG8_SB(0, 0), cB, voffB); PG8_STAGE(PG8_SB(0, 1), cB + hstepB, voffB); PG8_STAGE(PG8_SA(0, 0), cA, voffA); PG8_STAGE(PG8_SA(0, 1), cA + hstepA, voffA);
    if (wr == 1) PG8_BAR;
    PG8_WAIT_V(2); PG8_BAR;
    PG8_STAGE(PG8_SB(1, 0), cB + kstep, voffB); PG8_STAGE(PG8_SA(1, 0), cA + kstep, voffA); PG8_STAGE(PG8_SB(1, 1), cB + hstepB + kstep, voffB);
    PG8_WAIT_V(6); PG8_BAR;
    for (;;) {
        const bool has_next = S.next(ui + 1, nxt);
        const char* nA = has_next ? (const char*)g.A + (size_t)nxt.pm * tstepA + nxt.koff : cA; const char* nB = has_next ? (const char*)g.Bt + (size_t)nxt.pn * tstepB : cB;
#pragma nounroll
        for (int t = 0; t < nt; t += 2) {
            if constexpr (Epi::MIDHOOK) { if (t == 8 || t == 16) E.mid(acc, cur, t, wr, wc, fr, fq); }
            const bool last = (t == nt - 2);
            const char* a1 = cA + (size_t)(t + 1) * kstep;
            const char* a2 = last ? nA : cA + (size_t)(t + 2) * kstep; const char* b2 = last ? nB : cB + (size_t)(t + 2) * kstep;
            const char* a3 = a2 + kstep; const char* b3 = b2 + kstep;
            PG8_LDB(B0, 0, 0); PG8_LDB(B1, 0, 1); PG8_SCHED; PG8_LDA(At, 0, 0); PG8_STAGE(PG8_SA(1, 1), a1 + hstepA, voffA);
            PG8_WAIT_V(8); PG8_WAIT_L(0); PG8_BAR; PG8_MMA(0, 0, At, B0); PG8_MMA(0, 1, At, B1); PG8_BAR; PG8_SCHED;
            PG8_LDA(At, 0, 1); PG8_STAGE(PG8_SB(0, 0), b2, voffB); PG8_STAGE(PG8_SB(0, 1), b2 + hstepB, voffB); PG8_STAGE(PG8_SA(0, 0), a2, voffA);
            PG8_WAIT_V(8); PG8_WAIT_L(0); PG8_BAR; PG8_MMA(1, 0, At, B0); PG8_MMA(1, 1, At, B1); PG8_BAR; PG8_SCHED;
            PG8_LDB(B0, 1, 0); PG8_LDB(B1, 1, 1); PG8_SCHED; PG8_LDA(At, 1, 0); PG8_STAGE(PG8_SA(0, 1), a2 + hstepA, voffA);
            PG8_WAIT_V(8); PG8_WAIT_L(0); PG8_BAR; PG8_MMA(0, 0, At, B0); PG8_MMA(0, 1, At, B1); PG8_BAR; PG8_SCHED;
            PG8_LDA(At, 1, 1); PG8_STAGE(PG8_SB(1, 0), b3, voffB); PG8_STAGE(PG8_SB(1, 1), b3 + hstepB, voffB); PG8_STAGE(PG8_SA(1, 0), a3, voffA);
            PG8_WAIT_V(8); PG8_WAIT_L(0); PG8_BAR; PG8_MMA(1, 0, At, B0); PG8_MMA(1, 1, At, B1); PG8_BAR; PG8_SCHED;
        }
        if constexpr (ALIGN_EPI) { if (wr == 0) PG8_BAR; }
        E(acc, cur, wr, wc, fr, fq);
        if (!has_next) break;
#pragma unroll
        for (int a = 0; a < 2; ++a)
#pragma unroll
            for (int b = 0; b < 2; ++b)
#pragma unroll
                for (int m = 0; m < 4; ++m)
#pragma unroll
                    for (int n = 0; n < 2; ++n) acc[a][b][m][n] = (f32x4){0.f, 0.f, 0.f, 0.f};
        cur = nxt; cA = nA; cB = nB; ++ui;
        if constexpr (ALIGN_EPI) { if (wr == 1) PG8_BAR; }
    }
    PG8_WAIT_V(0);
    if constexpr (!ALIGN_EPI) { if (wr == 0) PG8_BAR; }
    PG8_BAR;
#undef PG8_SA
#undef PG8_SB
#undef PG8_STAGE
#undef PG8_LDA
#undef PG8_LDB
#undef PG8_MMA
#undef PG8_WAIT_V
#undef PG8_WAIT_L
#undef PG8_BAR
#undef PG8_SCHED
}
template <class Epi>
__device__ __forceinline__ void run_gemm(LAS unsigned char* lds, const bf16_t* A, int lda, const bf16_t* Bt, int M, int N, int K, const Epi& E) {
    Gemm g{A, Bt, lda, K}; StaticOrder S; S.init(M, N, NCU, (int)blockIdx.x);
    gemm_phase<Epi, StaticOrder, true, true>(lds, g, S, E);
}
template <int S_, int KP, class Epi>
__device__ __forceinline__ void run_gemm_split(LAS unsigned char* lds, const bf16_t* A, int lda, const bf16_t* Btp, int pm0, int ntiles, const Epi& E) {
    Gemm g{A, Btp, lda, KP}; SplitOrder<S_, KP> S; S.init(pm0, ntiles, NCU, (int)blockIdx.x);
    gemm_phase<Epi, SplitOrder<S_, KP>, true, true>(lds, g, S, E);
}
}

namespace att {
#define SBAR() __builtin_amdgcn_sched_barrier(0)
constexpr float THR = 8.f;
__device__ __forceinline__ int crow(int r, int hi) { return (r & 3) + 8 * (r >> 2) + 4 * hi; }
template <int DV> __device__ __forceinline__ int v_st(int k, int c) { const int kk = k; return ((kk >> 3) * (DV / 32) + (c >> 5)) * 512 + ((kk & 7) * 32 + (c & 31)) * 2; }
__device__ __forceinline__ int v_rd_base(int lane) { return ((lane & 3) << 3) | (((lane >> 2) & 3) << 6) | (((lane >> 4) & 1) << 5) | (((lane >> 5) & 1) << 8); }
template <int DV> constexpr int v_rd_off(int d0, int ks, int half) { return d0 * 512 + ks * (DV * 32) + half * (DV * 16); }
template <int OFF> __device__ __forceinline__ s16x4 tr_read(int vb) { s16x4 r; asm volatile("ds_read_b64_tr_b16 %0, %1 offset:%2" : "=&v"(r) : "v"(vb), "i"(OFF) : "memory"); return r; }

template <bool FIRST> __device__ __forceinline__ void partialSM(f32x16& p0, f32x16& p1, float& m_reg) {
    if constexpr (FIRST) {
        float pmax = p0[0];
#pragma unroll
        for (int r = 1; r < 16; ++r) pmax = fmaxf(pmax, p0[r]);
#pragma unroll
        for (int r = 0; r < 16; ++r) pmax = fmaxf(pmax, p1[r]);
        { auto rr = __builtin_amdgcn_permlane32_swap(__float_as_uint(pmax), __float_as_uint(pmax), false, false); pmax = fmaxf(__uint_as_float(rr[0]), __uint_as_float(rr[1])); }
        m_reg = bf_lo(cvt_pk_bf16(pmax, 0.f) & 0xffffu);
        const float mn = m_reg;
#pragma unroll
        for (int r = 0; r < 16; ++r) { p0[r] -= mn; p1[r] -= mn; }
    }
#pragma unroll
    for (int r = 0; r < 16; ++r) p0[r] = __builtin_amdgcn_exp2f(p0[r]);
}
__device__ __forceinline__ void finishSM(f32x16& p0, f32x16& p1, float& l_reg, bf16x8& pa0, bf16x8& pa1, bf16x8& pa2, bf16x8& pa3) {
#pragma unroll
    for (int r = 0; r < 16; ++r) p1[r] = __builtin_amdgcn_exp2f(p1[r]);
    float ps, psa = 0.f, psb = 0.f, psc = 0.f, psd = 0.f;
#pragma unroll
    for (int r = 0; r < 16; r += 4) { psa += p0[r]; psb += p0[r + 1]; psc += p0[r + 2]; psd += p0[r + 3]; }
#pragma unroll
    for (int r = 0; r < 16; r += 4) { psa += p1[r]; psb += p1[r + 1]; psc += p1[r + 2]; psd += p1[r + 3]; }
    ps = (psa + psb) + (psc + psd);
    { auto rr = __builtin_amdgcn_permlane32_swap(__float_as_uint(ps), __float_as_uint(ps), false, false); ps = __uint_as_float(rr[0]) + __uint_as_float(rr[1]); }
    l_reg += ps;
#define PK4(P, BASE, OUT) do { u32x4 w; w.x = cvt_pk_bf16(P[BASE + 0], P[BASE + 1]); w.y = cvt_pk_bf16(P[BASE + 2], P[BASE + 3]);   \
    w.z = cvt_pk_bf16(P[BASE + 4], P[BASE + 5]); w.w = cvt_pk_bf16(P[BASE + 6], P[BASE + 7]); OUT = __builtin_bit_cast(bf16x8, w); } while (0)
    PK4(p0, 0, pa0); PK4(p0, 8, pa1); PK4(p1, 0, pa2); PK4(p1, 8, pa3);
#undef PK4
}
template <int DK, bool BIAS> __device__ __forceinline__ void qkt(f32x16& p0, f32x16& p1, const LAS char* Ks, const bf16x8* qr, bf16x8 kone, bf16x8 qb, int r32, int hi) {
    constexpr int KS = DK * 2 + 16;
    p0 = f32x16{}; p1 = f32x16{};
#pragma unroll
    for (int d0 = 0; d0 < DK / 16; ++d0) {
        const bf16x8 b0 = *(const LAS bf16x8*)(Ks + r32 * KS + (2 * d0 + hi) * 16);
        const bf16x8 b1 = *(const LAS bf16x8*)(Ks + (32 + r32) * KS + (2 * d0 + hi) * 16);
        p0 = __builtin_amdgcn_mfma_f32_32x32x16_bf16(b0, qr[d0], p0, 0, 0, 0);
        p1 = __builtin_amdgcn_mfma_f32_32x32x16_bf16(b1, qr[d0], p1, 0, 0, 0); }
    if constexpr (BIAS) {
        p0 = __builtin_amdgcn_mfma_f32_32x32x16_bf16(kone, qb, p0, 0, 0, 0);
        p1 = __builtin_amdgcn_mfma_f32_32x32x16_bf16(kone, qb, p1, 0, 0, 0); }
}
struct VFr { s16x4 l0, h0, l1, h1, l2, h2, l3, h3; };
template <int DV, int D0> __device__ __forceinline__ void v_read(VFr& f, int vb) {
    f.l0 = tr_read<v_rd_off<DV>(D0, 0, 0)>(vb); f.h0 = tr_read<v_rd_off<DV>(D0, 0, 1)>(vb); f.l1 = tr_read<v_rd_off<DV>(D0, 1, 0)>(vb); f.h1 = tr_read<v_rd_off<DV>(D0, 1, 1)>(vb);
    f.l2 = tr_read<v_rd_off<DV>(D0, 2, 0)>(vb); f.h2 = tr_read<v_rd_off<DV>(D0, 2, 1)>(vb); f.l3 = tr_read<v_rd_off<DV>(D0, 3, 0)>(vb); f.h3 = tr_read<v_rd_off<DV>(D0, 3, 1)>(vb);
}
__device__ __forceinline__ void pv_mma(f32x16& od, const VFr& f, bf16x8 pa0, bf16x8 pa1, bf16x8 pa2, bf16x8 pa3) {
#define PK(L, H) (bf16x8){L[0], L[1], L[2], L[3], H[0], H[1], H[2], H[3]}
    od = __builtin_amdgcn_mfma_f32_32x32x16_bf16(pa0, PK(f.l0, f.h0), od, 0, 0, 0);
    od = __builtin_amdgcn_mfma_f32_32x32x16_bf16(pa1, PK(f.l1, f.h1), od, 0, 0, 0);
    od = __builtin_amdgcn_mfma_f32_32x32x16_bf16(pa2, PK(f.l2, f.h2), od, 0, 0, 0);
    od = __builtin_amdgcn_mfma_f32_32x32x16_bf16(pa3, PK(f.l3, f.h3), od, 0, 0, 0);
#undef PK
}
template <int DV> __device__ __forceinline__ void pv_all(f32x16* o, int vb, bf16x8 pa0, bf16x8 pa1, bf16x8 pa2, bf16x8 pa3) {
    VFr fa, fb;
    v_read<DV, 0>(fa, vb); v_read<DV, 1>(fb, vb);
    asm volatile("s_waitcnt lgkmcnt(8)" ::: "memory"); SBAR();
    pv_mma(o[0], fa, pa0, pa1, pa2, pa3);
    if constexpr (DV == 128) {
        SBAR(); v_read<DV, 2>(fa, vb);
        asm volatile("s_waitcnt lgkmcnt(8)" ::: "memory"); SBAR();
        pv_mma(o[1], fb, pa0, pa1, pa2, pa3);
        SBAR(); v_read<DV, 3>(fb, vb);
        asm volatile("s_waitcnt lgkmcnt(8)" ::: "memory"); SBAR();
        pv_mma(o[2], fa, pa0, pa1, pa2, pa3);
        asm volatile("s_waitcnt lgkmcnt(0)" ::: "memory"); SBAR();
        pv_mma(o[3], fb, pa0, pa1, pa2, pa3);
    } else {
        asm volatile("s_waitcnt lgkmcnt(0)" ::: "memory"); SBAR();
        pv_mma(o[1], fb, pa0, pa1, pa2, pa3);
    }
}
struct Stg { bf16x8 k0, k1, v0, v1; };
struct StgOff { unsigned k0, k1, v0, v1; };
template <int DK, int DV> __device__ __forceinline__ StgOff stg_offsets(int ldk, int ldv, int tid) {
    StgOff f; f.k0 = (unsigned)((tid >> 3) * ldk + (tid & 7) * 8) * 2u; f.k1 = (unsigned)((tid >> 2) * ldk + 64 + (tid & 3) * 8) * 2u;
    if constexpr (DV == 64) { f.v0 = (unsigned)((tid >> 3) * ldv + (tid & 7) * 8) * 2u; f.v1 = 0u; }
    else { f.v0 = (unsigned)((tid >> 4) * ldv + (tid & 15) * 8) * 2u; f.v1 = (unsigned)((32 + (tid >> 4)) * ldv + (tid & 15) * 8) * 2u; }
    return f;
}
template <int DK, int DV> __device__ __forceinline__ void sload(Stg& s, const bf16_t* Kt, const bf16_t* Vt, const StgOff& f, int tid) {
    s.k0 = *(const bf16x8*)((const char*)Kt + f.k0);
    if constexpr (DK == 96) { if (tid < 256) s.k1 = *(const bf16x8*)((const char*)Kt + f.k1); }
    s.v0 = *(const bf16x8*)((const char*)Vt + f.v0);
    if constexpr (DV == 128) s.v1 = *(const bf16x8*)((const char*)Vt + f.v1);
}
template <int DK, int DV> __device__ __forceinline__ void swrite(const Stg& s, LAS char* Kb, LAS char* Vb, int tid) {
    constexpr int KS = DK * 2 + 16;
    *(LAS bf16x8*)(Kb + (tid >> 3) * KS + (tid & 7) * 16) = s.k0;
    if constexpr (DK == 96) { if (tid < 256) *(LAS bf16x8*)(Kb + (tid >> 2) * KS + 128 + (tid & 3) * 16) = s.k1; }
    if constexpr (DV == 64) *(LAS bf16x8*)(Vb + v_st<DV>(tid >> 3, (tid & 7) * 8)) = s.v0;
    else { *(LAS bf16x8*)(Vb + v_st<DV>(tid >> 4, (tid & 15) * 8)) = s.v0; *(LAS bf16x8*)(Vb + v_st<DV>(32 + (tid >> 4), (tid & 15) * 8)) = s.v1; }
}
#define LBAR() asm volatile("s_waitcnt lgkmcnt(0)\n\ts_barrier" ::: "memory")
template <int DK, int DV, int MODE>
__device__ __forceinline__ void attn_unit(const bf16_t* __restrict__ Qb, int ldq, const bf16_t* __restrict__ Kc, const bf16_t* __restrict__ Kl, int ldk,
                                          const bf16_t* __restrict__ Vc, const bf16_t* __restrict__ Vl, int ldv, int NT,
                                          bf16_t* __restrict__ Ob, int ldo, float* scr, float lam, const float* gd, float osc, LAS char* lds) {
    constexpr int KS = DK * 2 + 16, KBYTES = 64 * KS, VBYTES = 64 * DV * 2, ND = DK / 16, NV = DV / 32;
    int tid_ = threadIdx.x; asm volatile("" : "+v"(tid_));
    const int tid = tid_, wid = tid >> 6, lane = tid & 63, r32 = lane & 31, hi = lane >> 5;
    LAS char* V_lds = lds; LAS char* K_lds = lds + 4 * VBYTES;
    LAS float* ws = (LAS float*)(lds + 4 * VBYTES + 4 * KBYTES) + wid * 64; LAS float* li_l = ws; LAS float* al_l = ws + 32;
    float m_reg = -1e30f, l_reg = 0.f; f32x16 o[NV]; bf16x8 qr[ND];
#pragma unroll
    for (int d = 0; d < NV; ++d) o[d] = f32x16{};
    const bf16_t* Qw = Qb + (size_t)(wid * 32 + r32) * ldq + hi * 8;
#pragma unroll
    for (int d0 = 0; d0 < ND; ++d0) qr[d0] = *(const bf16x8*)(Qw + d0 * 16);
    const int vb0 = (int)(unsigned)(uintptr_t)V_lds + v_rd_base(lane);
    Stg s0, s1; const StgOff sof = stg_offsets<DK, DV>(ldk, ldv, tid);
#define KT(t) (((t) < 4) ? Kc + (size_t)(t) * 64 * ldk : Kl + (size_t)((t) - 4) * 64 * ldk)
#define VT(t) (((t) < 4) ? Vc + (size_t)(t) * 64 * ldv : Vl + (size_t)((t) - 4) * 64 * ldv)
#define KB(t) (K_lds + ((t) & 3) * KBYTES)
#define VB(t) (V_lds + ((t) & 3) * VBYTES)
#define RESC(a) do { if (__any((a) < 1.f)) { if (hi == 0) al_l[r32] = (a); asm volatile("s_waitcnt lgkmcnt(0)" ::: "memory"); \
    _Pragma("unroll") for (int d = 0; d < NV; ++d) _Pragma("unroll") for (int r = 0; r < 16; ++r) o[d][r] *= al_l[crow(r, hi)]; } } while (0)
    f32x16 pA0, pA1, pB0, pB1; bf16x8 pa0, pa1, pa2, pa3;
    sload<DK, DV>(s0, KT(0), VT(0), sof, tid); sload<DK, DV>(s1, KT(1), VT(1), sof, tid);
    swrite<DK, DV>(s0, KB(0), VB(0), tid); swrite<DK, DV>(s1, KB(1), VB(1), tid);
    sload<DK, DV>(s0, KT(2), VT(2), sof, tid); sload<DK, DV>(s1, KT(3), VT(3), sof, tid);
    LBAR();
    bf16x8 kone = {0, 0, 0, 0, 0, 0, 0, 0}, qb = {0, 0, 0, 0, 0, 0, 0, 0};
    if (hi == 0) kone[0] = (short)0x3F80;
    qkt<DK, false>(pA0, pA1, KB(0), qr, kone, qb, r32, hi); partialSM<true>(pA0, pA1, m_reg);
    if (hi == 0) qb[0] = (short)(cvt_pk_bf16(-m_reg, 0.f) & 0xffffu);
    for (int j = 1; j + 1 < NT; j += 2) {
        LBAR();
        SBAR(); qkt<DK, true>(pB0, pB1, KB(j), qr, kone, qb, r32, hi);
        finishSM(pA0, pA1, l_reg, pa0, pa1, pa2, pa3); SBAR();
        swrite<DK, DV>(s0, KB(j + 1), VB(j + 1), tid);
        { const int tn = (j + 3 < NT) ? j + 3 : NT - 1; sload<DK, DV>(s0, KT(tn), VT(tn), sof, tid); }
        SBAR();
        pv_all<DV>(o, vb0 + ((j - 1) & 3) * VBYTES, pa0, pa1, pa2, pa3); partialSM<false>(pB0, pB1, m_reg);
        LBAR();
        SBAR(); qkt<DK, true>(pA0, pA1, KB(j + 1), qr, kone, qb, r32, hi);
        finishSM(pB0, pB1, l_reg, pa0, pa1, pa2, pa3); SBAR();
        swrite<DK, DV>(s1, KB(j + 2), VB(j + 2), tid);
        { const int tn = (j + 4 < NT) ? j + 4 : NT - 1; sload<DK, DV>(s1, KT(tn), VT(tn), sof, tid); }
        SBAR();
        pv_all<DV>(o, vb0 + (j & 3) * VBYTES, pa0, pa1, pa2, pa3); partialSM<false>(pA0, pA1, m_reg);
    }
    LBAR();
    SBAR(); qkt<DK, true>(pB0, pB1, KB(NT - 1), qr, kone, qb, r32, hi);
    finishSM(pA0, pA1, l_reg, pa0, pa1, pa2, pa3); SBAR();
    pv_all<DV>(o, vb0 + ((NT - 2) & 3) * VBYTES, pa0, pa1, pa2, pa3); partialSM<false>(pB0, pB1, m_reg);
    finishSM(pB0, pB1, l_reg, pa0, pa1, pa2, pa3); SBAR();
    pv_all<DV>(o, vb0 + ((NT - 1) & 3) * VBYTES, pa0, pa1, pa2, pa3);
    asm volatile("" ::: "memory");
    if (hi == 0) li_l[r32] = l_reg; asm volatile("s_waitcnt lgkmcnt(0)" ::: "memory");
    float rli[16];
#pragma unroll
    for (int r = 0; r < 16; ++r) rli[r] = __builtin_amdgcn_rcpf(li_l[crow(r, hi)]);
    if constexpr (MODE == 0) {
#pragma unroll
        for (int r = 0; r < 16; ++r) { bf16_t* op = Ob + (size_t)(wid * 32 + crow(r, hi)) * ldo + r32;
#pragma unroll
            for (int d0 = 0; d0 < NV; ++d0) op[d0 * 32] = (bf16_t)(cvt_pk_bf16(o[d0][r] * rli[r], 0.f) & 0xffffu); }
    } else if constexpr (MODE == 1) {
#pragma unroll
        for (int d0 = 0; d0 < NV; ++d0)
#pragma unroll
            for (int r4 = 0; r4 < 4; ++r4) ((f32x4*)scr)[(d0 * 4 + r4) * 512 + tid] = (f32x4){o[d0][4 * r4] * rli[4 * r4], o[d0][4 * r4 + 1] * rli[4 * r4 + 1], o[d0][4 * r4 + 2] * rli[4 * r4 + 2], o[d0][4 * r4 + 3] * rli[4 * r4 + 3]};
    } else {
        float gv[NV];
#pragma unroll
        for (int d0 = 0; d0 < NV; ++d0) gv[d0] = gd[d0 * 32 + r32] * osc;
#pragma unroll
        for (int r4 = 0; r4 < 4; ++r4) { f32x4 s4[NV];
#pragma unroll
            for (int d0 = 0; d0 < NV; ++d0) s4[d0] = ((const f32x4*)scr)[(d0 * 4 + r4) * 512 + tid];
#pragma unroll
          for (int rr = 0; rr < 4; ++rr) { const int r = 4 * r4 + rr; float od[NV]; float ss = 0.f;
#pragma unroll
            for (int d0 = 0; d0 < NV; ++d0) { od[d0] = s4[d0][rr] - lam * (o[d0][r] * rli[r]); ss += od[d0] * od[d0]; }
            ss = half32_sum(ss);
            const float rs = __builtin_amdgcn_rsqf(ss * (1.f / (float)DV) + EPS);
            bf16_t* op = Ob + (size_t)(wid * 32 + crow(r, hi)) * ldo + r32;
#pragma unroll
            for (int d0 = 0; d0 < NV; ++d0) op[d0 * 32] = (bf16_t)(cvt_pk_bf16(od[d0] * rs * gv[d0], 0.f) & 0xffffu); }
            asm volatile("" ::: "memory"); }
    }
    LBAR();
#undef KT
#undef VT
#undef KB
#undef VB
#undef RESC
}
#undef LBAR
#undef SBAR
}

struct Args { const float* in[28]; float* out; unsigned char* ws; };
enum { I_X = 0, I_C, I_CTX, I_CCTX, I_WMOD, I_BMOD, I_GN1, I_WIN, I_BGATE, I_LQ1, I_LK1, I_LQ2, I_LK2, I_GDIFF, I_GGQ, I_GGK, I_GMQ, I_WUQ, I_GMKV, I_WUKV,
       I_WBD, I_WBG, I_WBM, I_WOUT, I_GN2, I_WF1, I_WF2, I_GFIN };

__device__ __forceinline__ int map_row(int id, int n) {
    if (id == 1) { const int h = n / 96, off = n % 96; if (off < 64) return n; const int j = off - 64; const int i = (j & 7) + ((j >> 4) << 3), s = (j >> 3) & 1; return h * 96 + 64 + 2 * i + s; }
    if (id == 2) { const int h = n >> 7, j = n & 127; return j < 64 ? h * 64 + j : 512 + h * 64 + (j - 64); }
    if (id == 3) { const int isu = n >= FH ? 1 : 0; const int j = isu ? n - FH : n; return (j >> 7) * 256 + isu * 128 + (j & 127); }
    return n;
}
__device__ __forceinline__ void transpose_item(const float* W, int N, bf16_t* WT, int ld, int koff, int mapid, const float* kscale, LAS float* scr, int item, int lane) {
    const int nblk = N / 32, kb = item / nblk, nb = item % nblk, k0 = 64 * kb, n0 = 32 * nb;
    { float v[32];
#pragma unroll
      for (int i = 0; i < 32; ++i) { const int kk = 2 * i + (lane >> 5); v[i] = W[(size_t)(k0 + kk) * N + n0 + (lane & 31)]; }
#pragma unroll
      for (int i = 0; i < 32; ++i) { const int kk = 2 * i + (lane >> 5); float x = v[i]; if (kscale) x *= kscale[k0 + kk]; scr[kk * 33 + (lane & 31)] = x; } }
    asm volatile("s_waitcnt lgkmcnt(0)" ::: "memory");
    const int c = lane & 7;
#pragma unroll
    for (int j = 0; j < 4; ++j) { const int n = (lane >> 3) + 8 * j; const LAS float* s = scr + (8 * c) * 33 + n;
        u32x4 o; o.x = cvt_pk_bf16(s[0 * 33], s[1 * 33]); o.y = cvt_pk_bf16(s[2 * 33], s[3 * 33]); o.z = cvt_pk_bf16(s[4 * 33], s[5 * 33]); o.w = cvt_pk_bf16(s[6 * 33], s[7 * 33]);
        *(u32x4*)(WT + (size_t)map_row(mapid, n0 + n) * ld + koff + k0 + 8 * c) = o; }
    asm volatile("s_waitcnt lgkmcnt(0)" ::: "memory");
}

struct NRow { f32x4 v[4]; };
__device__ __forceinline__ void norm_load(NRow& r, const float* xrow, int lane) {
#pragma unroll
    for (int j = 0; j < 2; ++j) { r.v[2 * j] = *(const f32x4*)(xrow + 512 * j + 8 * lane); r.v[2 * j + 1] = *(const f32x4*)(xrow + 512 * j + 8 * lane + 4); }
}
template <int NP> __device__ __forceinline__ void norm_load_parts(NRow& r, const float* xrow, const float* prow, int lane) {
#pragma unroll
    for (int j = 0; j < 4; ++j) { const int c = 512 * (j >> 1) + 8 * lane + 4 * (j & 1); f32x4 v = *(const f32x4*)(xrow + c);
#pragma unroll
        for (int q = 0; q < NP; ++q) v += *(const f32x4*)(prow + (size_t)q * TCG * DM + c);
        r.v[j] = v; }
}
__device__ __forceinline__ void norm_finish(const NRow& r, float* cpy, const float* gn, const float* shift, const float* scale, bf16_t* orow, int lane) {
    float s = 0.f;
#pragma unroll
    for (int j = 0; j < 4; ++j) s += (r.v[j].x * r.v[j].x + r.v[j].y * r.v[j].y) + (r.v[j].z * r.v[j].z + r.v[j].w * r.v[j].w);
    if (cpy) {
#pragma unroll
        for (int j = 0; j < 4; ++j) *(f32x4*)(cpy + 512 * (j >> 1) + 8 * lane + 4 * (j & 1)) = r.v[j];
    }
    const float rs = __builtin_amdgcn_rsqf(wave_sum(s) * (1.f / DM) + EPS);
#pragma unroll
    for (int j = 0; j < 2; ++j) { const int c = 512 * j + 8 * lane;
        const f32x4 sh0 = *(const f32x4*)(shift + c), sh1 = *(const f32x4*)(shift + c + 4), gs0 = *(const f32x4*)(scale + c), gs1 = *(const f32x4*)(scale + c + 4);
        const f32x4 y0 = r.v[2 * j] * rs * gs0 + sh0, y1 = r.v[2 * j + 1] * rs * gs1 + sh1;
        u32x4 w; w.x = cvt_pk_bf16(y0.x, y0.y); w.y = cvt_pk_bf16(y0.z, y0.w); w.z = cvt_pk_bf16(y1.x, y1.y); w.w = cvt_pk_bf16(y1.z, y1.w); *(u32x4*)(orow + c) = w; }
}

struct PRow { u32x4 a, b, c, d; u32x2 m1, m2, qv; unsigned w0, w1, w2; };
__device__ __forceinline__ int post_base(int lane) { const int hd = lane >> 1; return (lane < 32) ? hd * 64 : C_GQ + (((hd - 16) < 10) ? (hd - 16) : 0) * 64; }
__device__ __forceinline__ void post_load(PRow& r, const bf16_t* zr, int lane) {
    const bf16_t* p1 = zr + post_base(lane) + 8 * (lane & 1);
    r.a = *(const u32x4*)p1; r.b = *(const u32x4*)(p1 + 16); r.c = *(const u32x4*)(p1 + 32); r.d = *(const u32x4*)(p1 + 48);
    const int q = lane & 3; const bf16_t* pm = zr + C_MKR + ((q < 2) ? 4 * q : 16 + 4 * (q - 2));
    r.m1 = *(const u32x2*)pm; r.m2 = *(const u32x2*)(pm + 8);
    { typedef unsigned u32x3_t __attribute__((ext_vector_type(3))); typedef u32x3_t u32x3_a4 __attribute__((aligned(4)));
      const u32x3_a4 w3 = *(const u32x3_a4*)(zr + C_MCQ + lane * 6); r.w0 = w3.x; r.w1 = w3.y; r.w2 = w3.z; }
    r.qv = *(const u32x2*)(zr + C_MCKV + lane * 4);
}
__device__ __forceinline__ void post_finish(PRow& r, bf16_t* zr, int row, float* rsq, float* rskv, bf16_t* kmr, const float* ggq, const float* ggk, int lane) {
    const bool lat = row < TLG; const int tk = row & (SEQ - 1);
    const float prow = lat ? (float)(tk >> 6) : 0.f, pcol = lat ? (float)(tk & 63) : 0.f;
    const int hf = lane & 1, hd = lane >> 1; const bool isg = lane >= 32; const int hg = hd - 16; const bool act = !isg || hg < 10;
    bf16_t* p1 = zr + post_base(lane) + 8 * hf;
    {
        float x1r[8] = {bf_lo(r.a.x), bf_hi(r.a.x), bf_lo(r.a.y), bf_hi(r.a.y), bf_lo(r.a.z), bf_hi(r.a.z), bf_lo(r.a.w), bf_hi(r.a.w)};
        float x2r[8] = {bf_lo(r.b.x), bf_hi(r.b.x), bf_lo(r.b.y), bf_hi(r.b.y), bf_lo(r.b.z), bf_hi(r.b.z), bf_lo(r.b.w), bf_hi(r.b.w)};
        float x1c[8] = {bf_lo(r.c.x), bf_hi(r.c.x), bf_lo(r.c.y), bf_hi(r.c.y), bf_lo(r.c.z), bf_hi(r.c.z), bf_lo(r.c.w), bf_hi(r.c.w)};
        float x2c[8] = {bf_lo(r.d.x), bf_hi(r.d.x), bf_lo(r.d.y), bf_hi(r.d.y), bf_lo(r.d.z), bf_hi(r.d.z), bf_lo(r.d.w), bf_hi(r.d.w)};
        float rs = 1.f;
        if (isg) {
            float ss = 0.f;
#pragma unroll
            for (int e = 0; e < 8; ++e) ss += (x1r[e] * x1r[e] + x2r[e] * x2r[e]) + (x1c[e] * x1c[e] + x2c[e] * x2c[e]);
            ss = xadd1(ss); rs = __builtin_amdgcn_rsqf(ss * (1.f / 64.f) + EPS);
            const float* gg = ((hg < 8) ? ggq : ggk) + 8 * hf;
#pragma unroll
            for (int e = 0; e < 8; ++e) { x1r[e] *= rs * gg[e]; x2r[e] *= rs * gg[16 + e]; x1c[e] *= rs * gg[32 + e]; x2c[e] *= rs * gg[48 + e]; }
        }
        const float sc = (isg ? hg < 8 : hd < 8) ? C2_64 : 1.f;
#pragma unroll
        for (int e = 0; e < 8; ++e) { const float f = __builtin_amdgcn_exp2f(-(float)(8 * hf + e) * (L2T / 16.f));
            rope_pair(x1r[e], x2r[e], prow * f); rope_pair(x1c[e], x2c[e], pcol * f);
            x1r[e] *= sc; x2r[e] *= sc; x1c[e] *= sc; x2c[e] *= sc; }
        u32x4 a, b, c, d;
        a.x = cvt_pk_bf16(x1r[0], x1r[1]); a.y = cvt_pk_bf16(x1r[2], x1r[3]); a.z = cvt_pk_bf16(x1r[4], x1r[5]); a.w = cvt_pk_bf16(x1r[6], x1r[7]);
        b.x = cvt_pk_bf16(x2r[0], x2r[1]); b.y = cvt_pk_bf16(x2r[2], x2r[3]); b.z = cvt_pk_bf16(x2r[4], x2r[5]); b.w = cvt_pk_bf16(x2r[6], x2r[7]);
        c.x = cvt_pk_bf16(x1c[0], x1c[1]); c.y = cvt_pk_bf16(x1c[2], x1c[3]); c.z = cvt_pk_bf16(x1c[4], x1c[5]); c.w = cvt_pk_bf16(x1c[6], x1c[7]);
        d.x = cvt_pk_bf16(x2c[0], x2c[1]); d.y = cvt_pk_bf16(x2c[2], x2c[3]); d.z = cvt_pk_bf16(x2c[4], x2c[5]); d.w = cvt_pk_bf16(x2c[6], x2c[7]);
        r.a = a; r.b = b; r.c = c; r.d = d;
    }
    const unsigned w0 = r.w0, w1 = r.w1, w2 = r.w2; const u32x2 qv = r.qv;
    float ssq = bf_lo(w0) * bf_lo(w0) + bf_hi(w0) * bf_hi(w0) + bf_lo(w1) * bf_lo(w1) + bf_hi(w1) * bf_hi(w1) + bf_lo(w2) * bf_lo(w2) + bf_hi(w2) * bf_hi(w2);
    ssq = wave_sum(ssq);
    float skv = bf_lo(qv.x) * bf_lo(qv.x) + bf_hi(qv.x) * bf_hi(qv.x) + bf_lo(qv.y) * bf_lo(qv.y) + bf_hi(qv.y) * bf_hi(qv.y);
    skv = wave_sum(skv);
    u32x4 mw;
    { const int q = lane & 3; const float pos = (q < 2) ? prow : pcol;
      float x1[4] = {bf_lo(r.m1.x), bf_hi(r.m1.x), bf_lo(r.m1.y), bf_hi(r.m1.y)}, x2[4] = {bf_lo(r.m2.x), bf_hi(r.m2.x), bf_lo(r.m2.y), bf_hi(r.m2.y)};
#pragma unroll
      for (int e = 0; e < 4; ++e) { const float f = __builtin_amdgcn_exp2f(-(float)(4 * (q & 1) + e) * (L2T / 8.f)); rope_pair(x1[e], x2[e], pos * f); }
      mw.x = cvt_pk_bf16(x1[0], x2[0]); mw.y = cvt_pk_bf16(x1[1], x2[1]); mw.z = cvt_pk_bf16(x1[2], x2[2]); mw.w = cvt_pk_bf16(x1[3], x2[3]); }
    if (act) { *(u32x4*)p1 = r.a; *(u32x4*)(p1 + 16) = r.b; *(u32x4*)(p1 + 32) = r.c; *(u32x4*)(p1 + 48) = r.d; }
    if (lane < 32) *(u32x4*)(kmr + (lane >> 2) * 96 + 64 + 8 * (lane & 3)) = mw;
    if (lane == 0) *(f32x2*)(rsq + 2 * row) = (f32x2){__builtin_amdgcn_rsqf(ssq * (1.f / 384.f) + EPS), __builtin_amdgcn_rsqf(skv * (1.f / 256.f) + EPS)};
}

#define XB_TMO      128
#define XB_XCNT(j)  (256  + 64 * (j))
#define XB_XSUB(j)  (1280 + 64 * (j))
#define XB_XGEN(j)  (2304 + 64 * (j))
#define XB_TOP      3328
#define XB_TOPGEN   3392
#define XCD_BAR_WORDS 3456
#define XB_SPIN_CAP (1u << 18)
__device__ __forceinline__ unsigned xb_ld(unsigned* p)              { return __hip_atomic_load(p, __ATOMIC_RELAXED, __HIP_MEMORY_SCOPE_AGENT); }
__device__ __forceinline__ unsigned xb_add(unsigned* p, unsigned v) { return __hip_atomic_fetch_add(p, v, __ATOMIC_RELAXED, __HIP_MEMORY_SCOPE_AGENT); }
__device__ __forceinline__ unsigned xb_xcc_id() { return (unsigned)__builtin_amdgcn_s_getreg((3 << 11) | 20) & 0xFu; }
#define XB_SPIN(cond, bar) do { unsigned _sp = 0; while (cond) { __builtin_amdgcn_s_sleep(1); \
    if ((++_sp & 255u) == 0u) { if (xb_ld(&(bar)[XB_TMO])) break; if (_sp > XB_SPIN_CAP) { atomicAdd(&(bar)[XB_TMO], 1u); break; } } } } while (0)
struct XcdBarrier { unsigned* bar; unsigned x; volatile LAS unsigned* st; };
__device__ __forceinline__ XcdBarrier xcd_barrier_post(unsigned* bar, volatile LAS unsigned* st) {
    XcdBarrier b; b.bar = bar; b.x = xb_xcc_id(); b.st = st;
    if (threadIdx.x == 0) (void)xb_add(&bar[XB_XCNT(b.x)], 1u);
    return b;
}
__device__ __forceinline__ void xcd_barrier_complete(unsigned* bar, unsigned x, unsigned& nloc, unsigned& nx) {
    const unsigned G = NCU;
    unsigned sum, cnt, mine, sp = 0u;
    for (;;) {
        sum = 0u; cnt = 0u; mine = 0u;
#pragma unroll
        for (unsigned j = 0; j < 16; ++j) { const unsigned c = xb_ld(&bar[XB_XCNT(j)]); sum += c; cnt += (c > 0u) ? 1u : 0u; mine = (j == x) ? c : mine; }
        if (sum == G) break;
        __builtin_amdgcn_s_sleep(1);
        if ((++sp & 255u) == 0u) { if (xb_ld(&bar[XB_TMO])) break; if (sp > XB_SPIN_CAP) { atomicAdd(&bar[XB_TMO], 1u); break; } }
    }
    nloc = mine > 0u ? mine : 1u; nx = cnt > 0u ? cnt : 1u;
}
__device__ __forceinline__ void xcd_barrier(unsigned* bar_, volatile LAS unsigned* st_) {
    XcdBarrier b; b.bar = bar_; b.st = st_;
    asm volatile("s_waitcnt vmcnt(0)" ::: "memory");
    __syncthreads();
    if (threadIdx.x == 0) {
        b.x = xb_xcc_id();
        unsigned* bar = b.bar;
        __builtin_amdgcn_s_waitcnt(0);
        unsigned nloc = b.st[0], nx = b.st[1];
        if (nloc == 0u) { xcd_barrier_complete(bar, b.x, nloc, nx); b.st[0] = nloc; b.st[1] = nx; }
        const unsigned old = xb_add(&bar[XB_XSUB(b.x)], 1u);
        const unsigned gen = old / nloc;
        if (old + 1u == (gen + 1u) * nloc) {
            __builtin_amdgcn_fence(__ATOMIC_RELEASE, "agent");
            asm volatile("s_waitcnt vmcnt(0)" ::: "memory");
            const unsigned og = xb_add(&bar[XB_TOP], 1u);
            const unsigned tg = og / nx;
            if (og + 1u == (tg + 1u) * nx) xb_add(&bar[XB_TOPGEN], 1u);
            else XB_SPIN(xb_ld(&bar[XB_TOPGEN]) == tg, bar);
            __builtin_amdgcn_fence(__ATOMIC_ACQUIRE, "agent");
            xb_add(&bar[XB_XGEN(b.x)], 1u);
            asm volatile("s_waitcnt vmcnt(0)" ::: "memory");
        } else {
            XB_SPIN(xb_ld(&bar[XB_XGEN(b.x)]) == gen, bar);
            __builtin_amdgcn_fence(__ATOMIC_ACQUIRE, "agent");
            asm volatile("s_waitcnt vmcnt(0)" ::: "memory");
        }
    }
    __syncthreads();
}

typedef __attribute__((address_space(4))) const Args* KArgs;
__device__ __forceinline__ void convert_layer(KArgs ap, unsigned char* ws, LAS float* scr, int cl, int w, int nw, int lane) {
    constexpr int N_IN = 16 * 189, N_UQ = 6 * 24, N_UKV = 4 * 32, N_BR = 8 * 32, N_OUT = 16 * 32, N_F1 = 16 * 176, N_F2 = 44 * 32;
    constexpr int N_L = N_IN + N_UQ + N_UKV + 3 * N_BR + N_OUT + N_F1 + N_F2;
    unsigned char* cw = ws + WS_W + (size_t)cl * WL_SZ;
    for (int it = w; it < N_L; it += nw) {
        int r = it;
        if (r < N_IN) { transpose_item(ap->in[I_WIN] + (size_t)cl * 1024 * INW, INW, (bf16_t*)(cw + WL_IN), 1024, 0, 0, nullptr, scr, r, lane); continue; } r -= N_IN;
        if (r < N_UQ) { transpose_item(ap->in[I_WUQ] + (size_t)cl * 384 * 768, 768, (bf16_t*)(cw + WL_UQ), 384, 0, 1, ap->in[I_GMQ] + cl * 384, scr, r, lane); continue; } r -= N_UQ;
        if (r < N_UKV) { transpose_item(ap->in[I_WUKV] + (size_t)cl * 256 * 1024, 1024, (bf16_t*)(cw + WL_UKV), 256, 0, 2, ap->in[I_GMKV] + cl * 256, scr, r, lane); continue; } r -= N_UKV;
        if (r < 3 * N_BR) { const int br = r / N_BR; const float* wb = (br == 0) ? ap->in[I_WBD] : (br == 1) ? ap->in[I_WBG] : ap->in[I_WBM];
            transpose_item(wb + (size_t)cl * 512 * 1024, 1024, (bf16_t*)(cw + WL_BR), 1536, br * 512, 0, nullptr, scr, r % N_BR, lane); continue; } r -= 3 * N_BR;
        if (r < N_OUT) { transpose_item(ap->in[I_WOUT] + (size_t)cl * 1024 * 1024, 1024, (bf16_t*)(cw + WL_OUT), 1024, 0, 0, nullptr, scr, r, lane); continue; } r -= N_OUT;
        if (r < N_F1) { transpose_item(ap->in[I_WF1] + (size_t)cl * 1024 * 2 * FH, 2 * FH, (bf16_t*)(cw + WL_F1), 1024, 0, 3, nullptr, scr, r, lane); continue; } r -= N_F1;
        transpose_item(ap->in[I_WF2] + (size_t)cl * FH * 1024, 1024, (bf16_t*)(cw + WL_F2), FH, 0, 0, nullptr, scr, r, lane);
    }
}
__device__ __forceinline__ void final_norm_row(float* xr, const float* gfin, int lane) {
    f32x4 v[4]; float s = 0.f;
#pragma unroll
    for (int j = 0; j < 4; ++j) { v[j] = *(const f32x4*)(xr + 256 * j + 4 * lane); s += (v[j].x * v[j].x + v[j].y * v[j].y) + (v[j].z * v[j].z + v[j].w * v[j].w); }
    const float rs = __builtin_amdgcn_rsqf(wave_sum(s) * (1.f / DM) + EPS);
#pragma unroll
    for (int j = 0; j < 4; ++j) { const f32x4 gf = *(const f32x4*)(gfin + 256 * j + 4 * lane); *(f32x4*)(xr + 256 * j + 4 * lane) = v[j] * rs * gf; }
}

#define PHASE_BEGIN() asm volatile("" : "+s"(g), "+s"(l)); unsigned lds_z = 0u; asm volatile("" : "+s"(lds_z)); LAS unsigned char* lds = lds_k + lds_z; int lane_t = (int)threadIdx.x; asm volatile("" : "+v"(lane_t)); const int lane = lane_t & 63; (void)lane; KArgs ap = (KArgs)__builtin_amdgcn_kernarg_segment_ptr(); asm volatile("" : "+s"(ap)); \
    unsigned char* ws = ap->ws; unsigned char* wl = ws + WS_W + (size_t)l * WL_SZ; (void)wl; \
    const float* modl = (const float*)(ws + WS_MOD) + (size_t)l * 17 * NMOD; (void)modl; \
    float* XL = ap->out + (size_t)g * TLG * DM; (void)XL; float* XCg = (float*)(ws + WS_XC) + (size_t)g * TCG * DM; (void)XCg; \
    bf16_t* XN = (bf16_t*)(ws + WS_XN); (void)XN; bf16_t* Z = (bf16_t*)(ws + WS_Z); (void)Z; bf16_t* O3 = (bf16_t*)(ws + WS_O3); (void)O3; \
    const int Mrows = (l == 0) ? TG : TLG; (void)Mrows;

__global__ void __launch_bounds__(512, 2) fwd_mega(Args args_unused) {
    extern __shared__ __attribute__((aligned(16))) unsigned char lds_raw[];
    cg::grid_group grid = cg::this_grid();
    LAS unsigned char* lds_k = (LAS unsigned char*)lds_raw;
    const int tid = threadIdx.x, wave = __builtin_amdgcn_readfirstlane(tid >> 6);
    constexpr int G = NCU; const int bx = blockIdx.x;
    __builtin_assume(bx >= 0 && bx < NCU);
    const int vcu = (G % 8 == 0) ? (bx % 8) * (G / 8) + bx / 8 : bx;
    const int gw = vcu * 8 + wave, NGW = G * 8;
    __builtin_assume(wave >= 0 && wave < 8); __builtin_assume(gw >= 0 && gw < NCU * 8);

    volatile LAS unsigned* bst = (volatile LAS unsigned*)(lds_k + 131072 + 512);
    if (tid < 2) bst[tid] = 0u;
    {
    int g = 0, l = 0; PHASE_BEGIN();
    if (bx == 0) { unsigned* bw = (unsigned*)ws; for (int i = tid; i < XCD_BAR_WORDS; i += 512) bw[i] = 0u; }
    if (bx < 192) {
        const int ml = bx / 96, ch = bx % 96;
        LAS float* S = (LAS float*)lds;
        LAS float* R = (LAS float*)(lds + 17 * 1024 * 4);
        const float* cin = ap->in[I_C]; const float* cctx = ap->in[I_CCTX];
        { float cv[34];
#pragma unroll
          for (int j = 0; j < 34; ++j) { const int i = tid + 512 * j, b = i >> 10, k = i & 1023; cv[j] = b < 16 ? cin[b * 1024 + k] : cctx[k]; }
#pragma unroll
          for (int j = 0; j < 34; ++j) S[tid + 512 * j] = cv[j] * sigmoidf(cv[j]); }
        __syncthreads();
        float acc[17];
#pragma unroll
        for (int b = 0; b < 17; ++b) acc[b] = 0.f;
        const float* wm = ap->in[I_WMOD] + (size_t)ml * 1024 * NMOD + ch * 64 + lane;
        for (int k0 = wave * 128; k0 < wave * 128 + 128; k0 += 16) {
            float w[16];
#pragma unroll
            for (int kk = 0; kk < 16; ++kk) w[kk] = wm[(size_t)(k0 + kk) * NMOD];
#pragma unroll
            for (int kk = 0; kk < 16; ++kk)
#pragma unroll
                for (int b = 0; b < 17; ++b) acc[b] += S[b * 1024 + k0 + kk] * w[kk]; }
#pragma unroll
        for (int b = 0; b < 17; ++b) R[(wave * 17 + b) * 64 + lane] = acc[b];
        __syncthreads();
        float* MOD = (float*)(ws + WS_MOD); const float* bmod = ap->in[I_BMOD];
        for (int i = tid; i < 17 * 64; i += 512) { const int b = i >> 6, ln = i & 63; float s = bmod[ml * NMOD + ch * 64 + ln];
#pragma unroll
            for (int w = 0; w < 8; ++w) s += R[(w * 17 + b) * 64 + ln];
            { const int col = ch * 64 + ln, mi = col >> 10, cc = col & 1023;
              if (mi == 1) s = ap->in[I_GN1][ml * DM + cc] * (1.f + s); else if (mi == 4) s = ap->in[I_GN2][ml * DM + cc] * (1.f + s); }
            MOD[((size_t)ml * 17 + b) * NMOD + ch * 64 + ln] = s; }
        __syncthreads();
    }
    {
        convert_layer(ap, ws, (LAS float*)(lds + wave * 16384), 0, gw, NGW, lane);
        for (int it = gw; it < 3 * 8 * 32; it += NGW) {
            const int br = it / 256; const float* wb = (br == 0) ? ap->in[I_WBD] : (br == 1) ? ap->in[I_WBG] : ap->in[I_WBM];
            transpose_item(wb, 1024, (bf16_t*)(ws + WS_WP6) + (size_t)br * 1024 * 512, 512, 0, 0, nullptr, (LAS float*)(lds + wave * 16384), it % 256, lane); }
        for (int it = gw; it < 16 * 32 + 44 * 32; it += NGW) {
            LAS float* scr = (LAS float*)(lds + wave * 16384);
            if (it < 16 * 32) { const int kb = it / 32, part = kb >> 2;
                transpose_item(ap->in[I_WOUT], 1024, (bf16_t*)(ws + WS_WP7) + (size_t)part * 1024 * 256, 256, -part * 256, 0, nullptr, scr, it, lane); }
            else { const int r2 = it - 16 * 32, kb = r2 / 32, part = kb / 22;
                transpose_item(ap->in[I_WF2], 1024, (bf16_t*)(ws + WS_WP10) + (size_t)part * 1024 * 1408, 1408, -part * 1408, 0, nullptr, scr, r2, lane); }
        }
        for (int i = bx * 512 + tid; i < 2 * 96 * 128; i += G * 512) { const int cl = i / (96 * 128), r = i % (96 * 128);
            *(u32x4*)(ws + WS_W + (size_t)cl * WL_SZ + WL_IN + ((size_t)INW * 1024 + (size_t)r * 8) * 2) = (u32x4){0u, 0u, 0u, 0u}; }
    }
    }
    grid.sync();
    { KArgs ap0 = (KArgs)__builtin_amdgcn_kernarg_segment_ptr(); (void)xcd_barrier_post((unsigned*)ap0->ws, bst); }
#define GRID_BAR() do { KArgs apb = (KArgs)__builtin_amdgcn_kernarg_segment_ptr(); asm volatile("" : "+s"(apb)); xcd_barrier((unsigned*)apb->ws, (volatile LAS unsigned*)(lds_k + 131072 + 512)); } while (0)

    for (int g = 0; g < NG; ++g) {
        for (int l = 0; l < DEPTH; ++l) {
            { PHASE_BEGIN();
              const float* xin = ap->in[I_X]; const float* cxin = ap->in[I_CTX]; const float* gn = ap->in[I_GN1] + l * DM;
#define A1_SRC(row, src, cpy, mp) const float* src; float* cpy = nullptr; const float* mp; { const bool lat = (row) < TLG; const int b = lat ? g * GB + ((row) >> 11) : 16; mp = modl + (size_t)b * NMOD; \
                if (lat) { if (l == 0) { src = xin + ((size_t)g * TLG + (row)) * DM; } else src = XL + (size_t)(row) * DM; } \
                else { const int rc = (row) - TLG; if (l == 0) { src = cxin + ((size_t)g * TCG + rc) * DM; cpy = XCg + (size_t)rc * DM; } else src = XCg + (size_t)rc * DM; } }
              for (int row = gw; row < TG; row += 3 * NGW) {
                const bool v1 = row + NGW < TG, v2 = row + 2 * NGW < TG; const int r1 = v1 ? row + NGW : row, r2 = v2 ? row + 2 * NGW : row;
                A1_SRC(row, s0, c0, m0) A1_SRC(r1, s1, c1, m1) A1_SRC(r2, s2, c2, m2)
                NRow n0, n1, n2;
                const float* P = (const float*)(ws + WS_QM);
                if (l == 1 && row >= TLG) { norm_load_parts<2>(n0, s0, P + (size_t)(row - TLG) * DM, lane); c0 = XCg + (size_t)(row - TLG) * DM; } else norm_load(n0, s0, lane);
                if (l == 1 && r1 >= TLG) { norm_load_parts<2>(n1, s1, P + (size_t)(r1 - TLG) * DM, lane); c1 = XCg + (size_t)(r1 - TLG) * DM; } else norm_load(n1, s1, lane);
                if (l == 1 && r2 >= TLG) { norm_load_parts<2>(n2, s2, P + (size_t)(r2 - TLG) * DM, lane); c2 = XCg + (size_t)(r2 - TLG) * DM; } else norm_load(n2, s2, lane);
                norm_finish(n0, c0, gn, m0, m0 + DM, XN + (size_t)row * DM, lane);
                if (v1) norm_finish(n1, c1, gn, m1, m1 + DM, XN + (size_t)r1 * DM, lane);
                if (v2) norm_finish(n2, c2, gn, m2, m2 + DM, XN + (size_t)r2 * DM, lane);
              } }
#undef A1_SRC
            GRID_BAR();
#ifndef X_NO_A2
            { PHASE_BEGIN(); pg8::EpiBf16 E{Z, ZW}; pg8::run_gemm(lds, XN, DM, (const bf16_t*)(wl + WL_IN), TG, ZW, DM, E); }
#endif
            GRID_BAR();
            { PHASE_BEGIN();
              float* RSQ = (float*)(ws + WS_RS); float* RSKV = RSQ + TG; bf16_t* KM = (bf16_t*)(ws + WS_KM);
              const float* ggq = ap->in[I_GGQ] + l * 64; const float* ggk = ap->in[I_GGK] + l * 64;
              for (int row = gw; row < TG; row += 3 * NGW) {
                const bool v1 = row + NGW < TG, v2 = row + 2 * NGW < TG; const int r1 = v1 ? row + NGW : row, r2 = v2 ? row + 2 * NGW : row;
                PRow p0, p1, p2; post_load(p0, Z + (size_t)row * ZW, lane); post_load(p1, Z + (size_t)r1 * ZW, lane); post_load(p2, Z + (size_t)r2 * ZW, lane);
                asm volatile("" ::: "memory");
                post_finish(p0, Z + (size_t)row * ZW, row, RSQ, RSKV, KM + (size_t)row * 768, ggq, ggk, lane);
                if (v1) post_finish(p1, Z + (size_t)r1 * ZW, r1, RSQ, RSKV, KM + (size_t)r1 * 768, ggq, ggk, lane);
                if (v2) post_finish(p2, Z + (size_t)r2 * ZW, r2, RSQ, RSKV, KM + (size_t)r2 * 768, ggq, ggk, lane);
              } }
            GRID_BAR();
#ifndef X_NO_A4
            { PHASE_BEGIN(); float* RSQ = (float*)(ws + WS_RS); pg8::EpiMlaQ E{(bf16_t*)(ws + WS_QM), RSQ}; pg8::run_gemm(lds, Z + C_MCQ, ZW, (const bf16_t*)(wl + WL_UQ), TG, 768, 384, E); }
            { PHASE_BEGIN(); float* RSKV = (float*)(ws + WS_RS) + 1; pg8::EpiMlaKV E{(bf16_t*)(ws + WS_KM), (bf16_t*)(ws + WS_VM), RSKV}; pg8::run_gemm(lds, Z + C_MCKV, ZW, (const bf16_t*)(wl + WL_UKV), TG, 1024, 256, E); }
#endif
            GRID_BAR();
#ifndef X_NO_A5
            { PHASE_BEGIN();
                const float lam_init = (l == 0) ? 0.2f : 0.35550906759096934f;
                float lam;
                { float a = ap->in[I_LQ1][l * 64 + lane] * ap->in[I_LK1][l * 64 + lane], b = ap->in[I_LQ2][l * 64 + lane] * ap->in[I_LK2][l * 64 + lane];
                  a = wave_sum(a); b = wave_sum(b); lam = fast_exp(a) - fast_exp(b) + lam_init; }
                const float* gd = ap->in[I_GDIFF] + l * 128; const float osc = 1.f - lam_init;
                const int nunits = (l == 0) ? 1440 : 1280;
                LAS char* al = (LAS char*)lds;
                float* SCR = (float*)(ws + WS_SCR) + (size_t)bx * 32768;
                const bf16_t* QM = (const bf16_t*)(ws + WS_QM); const bf16_t* KM = (const bf16_t*)(ws + WS_KM); const bf16_t* VM = (const bf16_t*)(ws + WS_VM);
                for (int i = 0;; ++i) {
                    const int idx = i * 256 + vcu; if (idx >= nunits) break;
                    int type, bl, h, qrow, NT;
                    if (idx < 1280) { NT = 36;
                        if (idx < 256) { type = 0; bl = idx >> 5; h = (idx >> 3) & 3; qrow = bl * SEQ + (idx & 7) * 256; }
                        else if (idx < 768) { const int j = idx - 256; type = 1; bl = j >> 6; h = (j >> 3) & 7; qrow = bl * SEQ + (j & 7) * 256; }
                        else { const int j = idx - 768; type = 2; bl = j >> 6; h = (j >> 3) & 7; qrow = bl * SEQ + (j & 7) * 256; }
                    } else { const int j = idx - 1280; NT = 4;
                        if (j < 32) { type = 0; bl = j >> 2; h = j & 3; } else if (j < 96) { type = 1; bl = (j - 32) >> 3; h = (j - 32) & 7; } else { type = 2; bl = (j - 96) >> 3; h = (j - 96) & 7; }
                        qrow = TLG + bl * CTXL; }
                    const size_t cr = (size_t)(TLG + bl * CTXL), lr = (size_t)bl * SEQ;
                    if (type == 0) {
#ifndef X_NO_T0
                        const bf16_t* q = Z + (size_t)qrow * ZW + C_DQ + h * 128; const bf16_t* kc = Z + cr * ZW + C_DK + h * 128; const bf16_t* kl = Z + lr * ZW + C_DK + h * 128;
                        const bf16_t* vc = Z + cr * ZW + C_DV + h * 128; const bf16_t* vl = Z + lr * ZW + C_DV + h * 128;
                        bf16_t* ob = O3 + (size_t)qrow * 1536 + h * 128;
                        att::attn_unit<64, 128, 1>(q, ZW, kc, kl, ZW, vc, vl, ZW, NT, ob, 1536, SCR, lam, gd, osc, al);
                        att::attn_unit<64, 128, 2>(q + 64, ZW, kc + 64, kl + 64, ZW, vc, vl, ZW, NT, ob, 1536, SCR, lam, gd, osc, al);
#endif
                    } else if (type == 1) {
#ifndef X_NO_T1
                        const int hk = h >> 2;
                        att::attn_unit<64, 64, 0>(Z + (size_t)qrow * ZW + C_GQ + h * 64, ZW, Z + cr * ZW + C_GK + hk * 64, Z + lr * ZW + C_GK + hk * 64, ZW,
                                                  Z + cr * ZW + C_GV + hk * 64, Z + lr * ZW + C_GV + hk * 64, ZW, NT, O3 + (size_t)qrow * 1536 + 512 + h * 64, 1536, SCR, lam, gd, osc, al);
#endif
                    } else {
#ifndef X_NO_T2
                        att::attn_unit<96, 64, 0>(QM + (size_t)qrow * 768 + h * 96, 768, KM + cr * 768 + h * 96, KM + lr * 768 + h * 96, 768,
                                                  VM + cr * 512 + h * 64, VM + lr * 512 + h * 64, 512, NT, O3 + (size_t)qrow * 1536 + 1024 + h * 64, 1536, SCR, lam, gd, osc, al);
#endif
                    }
                }
            }
#endif
            GRID_BAR();
#ifndef X_NO_A6
            { PHASE_BEGIN(); pg8::EpiGate E{Z, ap->in[I_BGATE] + l * 3072, XN}; pg8::run_gemm(lds, O3, 1536, (const bf16_t*)(wl + WL_BR), TLG, 1024, 1536, E); }
            if (l == 0) { PHASE_BEGIN(); pg8::EpiGateP E{Z, ap->in[I_BGATE], (float*)(ws + WS_QM + 32 * MiB)}; pg8::run_gemm_split<3, 512>(lds, O3, 1536, (const bf16_t*)(ws + WS_WP6), TLG / 256, TCG / 256, E); }
#endif
            GRID_BAR();
#ifndef X_NO_A7
            if (l == 0) { PHASE_BEGIN();
                const float* PG = (const float*)(ws + WS_QM + 32 * MiB);
                for (int row = gw; row < TCG; row += NGW) {
#pragma unroll
                    for (int j = 0; j < 4; ++j) { const size_t o = (size_t)row * DM + 256 * j + 4 * lane;
                        const f32x4 y = *(const f32x4*)(PG + o) + *(const f32x4*)(PG + (size_t)TCG * DM + o) + *(const f32x4*)(PG + (size_t)2 * TCG * DM + o);
                        u32x2 w; w.x = cvt_pk_bf16(y.x, y.y); w.y = cvt_pk_bf16(y.z, y.w); *(u32x2*)(XN + (size_t)TLG * DM + o) = w; } } }
            { PHASE_BEGIN(); const float* xrd = (l == 0) ? ap->in[I_X] + (size_t)g * TLG * DM : XL;
              pg8::EpiResid E{XL, xrd, modl, g, 2 * DM}; pg8::run_gemm(lds, XN, DM, (const bf16_t*)(wl + WL_OUT), TLG, 1024, 1024, E); }
            if (l == 0) GRID_BAR();
            if (l == 0) { PHASE_BEGIN(); pg8::EpiPartial E{(float*)(ws + WS_QM), modl, 2 * DM}; pg8::run_gemm_split<4, 256>(lds, XN, DM, (const bf16_t*)(ws + WS_WP7), TLG / 256, TCG / 256, E); }
#endif
            GRID_BAR();
            { PHASE_BEGIN();
              const float* gn = ap->in[I_GN2] + l * DM;
              for (int row = gw; row < Mrows; row += 2 * NGW) {
                const int r1 = row + NGW; const bool v1 = r1 < Mrows; const int r1c = v1 ? r1 : row;
                const bool lat0 = row < TLG, lat1 = r1c < TLG;
                const float* mp0 = modl + (size_t)(lat0 ? g * GB + (row >> 11) : 16) * NMOD; const float* mp1 = modl + (size_t)(lat1 ? g * GB + (r1c >> 11) : 16) * NMOD;
                const float* s0 = lat0 ? XL + (size_t)row * DM : XCg + (size_t)(row - TLG) * DM; const float* s1 = lat1 ? XL + (size_t)r1c * DM : XCg + (size_t)(r1c - TLG) * DM;
                NRow n0, n1; float* c0 = nullptr; float* c1 = nullptr;
                if (!lat0) { const float* P = (const float*)(ws + WS_QM);
                    norm_load_parts<4>(n0, s0, P + (size_t)(row - TLG) * DM, lane); c0 = XCg + (size_t)(row - TLG) * DM; } else norm_load(n0, s0, lane);
                if (!lat1) { const float* P = (const float*)(ws + WS_QM);
                    norm_load_parts<4>(n1, s1, P + (size_t)(r1c - TLG) * DM, lane); c1 = XCg + (size_t)(r1c - TLG) * DM; } else norm_load(n1, s1, lane);
                norm_finish(n0, c0, gn, mp0 + 3 * DM, mp0 + 4 * DM, XN + (size_t)row * DM, lane);
                if (v1) norm_finish(n1, c1, gn, mp1 + 3 * DM, mp1 + 4 * DM, XN + (size_t)r1 * DM, lane);
              } }
            GRID_BAR();
#ifndef X_NO_A9
            { PHASE_BEGIN(); pg8::EpiSwiGLU E{Z}; pg8::run_gemm(lds, XN, DM, (const bf16_t*)(wl + WL_F1), Mrows, 2 * FH, DM, E); }
#endif
            GRID_BAR();
#ifndef X_NO_A10
            { PHASE_BEGIN(); pg8::EpiResid E{XL, XL, modl, g, 5 * DM}; pg8::run_gemm(lds, Z, FH, (const bf16_t*)(wl + WL_F2), TLG, 1024, FH, E); }
            if (l == 0) { PHASE_BEGIN(); pg8::EpiPartial E{(float*)(ws + WS_QM), modl, 5 * DM}; pg8::run_gemm_split<2, 1408>(lds, Z, FH, (const bf16_t*)(ws + WS_WP10), TLG / 256, TCG / 256, E); }
            if (l == 0 && bx >= 64) { PHASE_BEGIN();
                const int w = (bx - 64) * 8 + wave, nw = (NCU - 64) * 8;
                if (g == 0) convert_layer(ap, ws, (LAS float*)(lds + wave * 16384), 1, w, nw, lane);
                else { const float* gfin = ap->in[I_GFIN]; float* outp = ap->out; for (int row = w; row < TLG; row += nw) final_norm_row(outp + (size_t)row * DM, gfin, lane); }
            }
#endif
            GRID_BAR();
        }
    }
    static_assert(NG == 2, "the side-job split of the final norm assumes two groups");
    { int g = 0, l = 0; PHASE_BEGIN();
      const float* gfin = ap->in[I_GFIN]; float* outp = ap->out;
      for (int row = TLG + gw; row < NB * SEQ; row += NGW) final_norm_row(outp + (size_t)row * DM, gfin, lane); }
}

extern "C" void kernel_launch(void* const* d_in, const int* in_sizes, int n_in, void* d_out, int out_size, void* d_ws, size_t ws_size, hipStream_t stream) {
    static int grid = 0;
    if (grid == 0) {
        if (n_in != 28 || out_size != NB * SEQ * DM || ws_size < WS_END) { fprintf(stderr, "kernel_launch: unexpected shapes (n_in %d out %d ws %zu need %zu)\n", n_in, out_size, ws_size, (size_t)WS_END); grid = -1; return; }
        int dev = 0, cus = 0, per_cu = 0;
        (void)hipGetDevice(&dev);
        (void)hipDeviceGetAttribute(&cus, hipDeviceAttributeMultiprocessorCount, dev);
        (void)hipFuncSetAttribute((const void*)fwd_mega, hipFuncAttributeMaxDynamicSharedMemorySize, LDS_BYTES);
        (void)hipOccupancyMaxActiveBlocksPerMultiprocessor(&per_cu, (const void*)fwd_mega, 512, LDS_BYTES);
        if (per_cu < 1) { fprintf(stderr, "kernel_launch: occupancy query says %d blocks/CU\n", per_cu); per_cu = 1; }
        grid = NCU;
        if (cus * per_cu < NCU) fprintf(stderr, "kernel_launch: device holds %d x %d workgroups, the kernel needs %d co-resident\n", cus, per_cu, NCU);
        fprintf(stderr, "kernel_launch: grid %d (cus %d, per_cu %d)\n", grid, cus, per_cu);
    }
    if (grid < 0) return;
    Args a{};
    for (int i = 0; i < 28; ++i) a.in[i] = (const float*)d_in[i];
    a.out = (float*)d_out; a.ws = (unsigned char*)d_ws;
    void* kargs[] = {&a};
    hipError_t e = hipLaunchCooperativeKernel((const void*)fwd_mega, dim3(grid), dim3(512), kargs, LDS_BYTES, stream);
    if (e != hipSuccess) fprintf(stderr, "kernel_launch: cooperative launch failed: %s (grid %d)\n", hipGetErrorString(e), grid);
}
```

```cpp
#include <hip/hip_runtime.h>
#include <hip/hip_cooperative_groups.h>
#include <cstdio>
#include <cstdint>
namespace cg = cooperative_groups;

#define LAS __attribute__((address_space(3)))
typedef unsigned short bf16_t;
typedef short bf16x8 __attribute__((ext_vector_type(8)));
typedef short s16x4 __attribute__((ext_vector_type(4)));
typedef float f32x2 __attribute__((ext_vector_type(2)));
typedef float f32x4 __attribute__((ext_vector_type(4)));
typedef float f32x16 __attribute__((ext_vector_type(16)));
typedef unsigned u32x2 __attribute__((ext_vector_type(2)));
typedef unsigned u32x4 __attribute__((ext_vector_type(4)));

constexpr int DM = 1024, NB = 16, SEQ = 2048, CTXL = 256, DEPTH = 2;
constexpr int GB = 8;
constexpr int NG = NB / GB;
constexpr int TLG = GB * SEQ;
constexpr int TCG = GB * CTXL;
constexpr int TG = TLG + TCG;
constexpr int ZW = 6144, INW = 6048;
constexpr int C_DQ = 0, C_DK = 512, C_DV = 1024, C_GQ = 1536, C_GK = 2048, C_GV = 2176, C_MCQ = 2304, C_MCKV = 2688, C_MKR = 2944, C_GT = 2976;
constexpr int FH = 2816, NMOD = 6 * DM;
constexpr float EPS = 1e-6f;
constexpr float LOG2E = 1.4426950408889634f;
constexpr float C2_64 = 0.125f * LOG2E;
constexpr float C2_96 = 0.10206207261596575f * LOG2E;
constexpr float L2T = 13.287712379549449f;
constexpr float INV2PI = 0.15915494309189535f;

constexpr size_t MiB = 1u << 20;
constexpr size_t WS_MOD = 1 * MiB;
constexpr size_t WS_RS = 2 * MiB;
constexpr size_t WS_W = 3 * MiB;
constexpr size_t WL_IN = 0, WL_UQ = 12 * MiB, WL_UKV = 13 * MiB, WL_BR = 14 * MiB, WL_OUT = 17 * MiB, WL_F1 = 19 * MiB, WL_F2 = 30 * MiB, WL_SZ = 36 * MiB;
constexpr size_t WS_XC = 75 * MiB;
constexpr size_t WS_XN = 91 * MiB;
constexpr size_t WS_Z = 127 * MiB;
constexpr size_t WS_QM = 343 * MiB;
constexpr size_t WS_KM = 370 * MiB;
constexpr size_t WS_VM = 397 * MiB;
constexpr size_t WS_O3 = 415 * MiB;
constexpr size_t WS_SCR = 469 * MiB;
constexpr size_t WS_WP7 = 501 * MiB;
constexpr size_t WS_WP10 = 503 * MiB;
constexpr size_t WS_WP6 = 509 * MiB;
constexpr size_t WS_END = 512 * MiB;
static_assert(WS_XN + (size_t)TG * 1024 * 2 <= WS_Z && WS_Z + (size_t)TG * ZW * 2 <= WS_QM && WS_QM + (size_t)TG * 768 * 2 <= WS_KM && WS_KM + (size_t)TG * 768 * 2 <= WS_VM &&
              WS_VM + (size_t)TG * 512 * 2 <= WS_O3 && WS_O3 + (size_t)TG * 1536 * 2 <= WS_SCR && WS_SCR + 256 * 131072 <= WS_END, "ws map");

constexpr int LDS_BYTES = 147456;
constexpr int NCU = 256;

__device__ __forceinline__ unsigned cvt_pk_bf16(float lo, float hi) { unsigned r; asm volatile("v_cvt_pk_bf16_f32 %0, %1, %2" : "=v"(r) : "v"(lo), "v"(hi)); return r; }
__device__ __forceinline__ float bf_lo(unsigned w) { return __uint_as_float(w << 16); }
__device__ __forceinline__ float bf_hi(unsigned w) { return __uint_as_float(w & 0xffff0000u); }
__device__ __forceinline__ float bf1(bf16_t v) { return __uint_as_float(((unsigned)v) << 16); }
template <int CTRL> __device__ __forceinline__ float dpp_f(float v) { return __builtin_bit_cast(float, __builtin_amdgcn_update_dpp(0, __builtin_bit_cast(int, v), CTRL, 0xF, 0xF, true)); }
__device__ __forceinline__ float xadd1(float v) { return v + dpp_f<0xB1>(v); }
__device__ __forceinline__ float xadd2(float v) { return v + dpp_f<0x4E>(v); }
__device__ __forceinline__ float row16_sum(float v) { v = xadd1(v); v = xadd2(v); v += dpp_f<0x141>(v); v += dpp_f<0x140>(v); return v; }
__device__ __forceinline__ float half32_sum(float v) { v = row16_sum(v); v += __builtin_bit_cast(float, __builtin_amdgcn_ds_swizzle(__builtin_bit_cast(int, v), 0x401F)); return v; }
__device__ __forceinline__ float wave_sum(float v) {
    v = half32_sum(v);
    auto rr = __builtin_amdgcn_permlane32_swap(__float_as_uint(v), __float_as_uint(v), false, false);
    return __uint_as_float(rr[0]) + __uint_as_float(rr[1]);
}
__device__ __forceinline__ float fast_exp(float x) { return __builtin_amdgcn_exp2f(x * LOG2E); }
__device__ __forceinline__ float sigmoidf(float x) { return __builtin_amdgcn_rcpf(1.f + fast_exp(-x)); }
__device__ __forceinline__ void rope_pair(float& x1, float& x2, float ang) {
    const float rv = ang * INV2PI; const float s = __builtin_amdgcn_sinf(rv), c = __builtin_amdgcn_cosf(rv);
    const float a = x1 * c - x2 * s, b = x1 * s + x2 * c; x1 = a; x2 = b;
}

namespace pg8 {
constexpr int BM = 256, BK = 64, HALF = 128, HTB = HALF * BK * 2, STAGE_BYTES = 8 * HTB, NXCD = 8, WGM = 8;
__host__ __device__ __forceinline__ int lds_byte(int r, int c) { const int st = (r >> 4) * 2 + (c >> 5), rr = r & 15, cc = c & 31, ob = rr * 64 + cc * 2; return st * 1024 + (ob ^ (((ob >> 9) & 1) << 5)); }
__host__ __device__ __forceinline__ void stage_rc(int b, int& R, int& C) { const int st = b / 1024, sb = b % 1024, swz = sb ^ (((sb >> 9) & 1) << 5); R = (st >> 1) * 16 + swz / 64; C = (st & 1) * 32 + (swz % 64) / 2; }
__host__ __device__ __forceinline__ int perm32(int rho) { const int n = rho >> 4, i = rho & 15; return 8 * (i >> 2) + 4 * n + (i & 3); }

struct Unit { int pm, pn, koff; };
struct Gemm { const bf16_t* A; const bf16_t* Bt; int lda; int K; };

struct StaticOrder {
    int nM, nN, nwg, G, c;
    __device__ void init(int M, int N, int G_, int c_) { nM = M / BM; nN = N / BM; nwg = nM * nN; G = G_; c = c_; }
    __device__ bool next(int i, Unit& u) const {
        const long L = (long)i * G + c; if (L >= nwg) return false;
        int wgid = (int)L; { const int q = nwg / NXCD, r = nwg % NXCD, xcd = wgid % NXCD, off = wgid / NXCD; wgid = (xcd < r ? xcd * (q + 1) : r * (q + 1) + (xcd - r) * q) + off; }
        const int nig = WGM * nN, gid = wgid / nig, fm = gid * WGM, gsz = (nM - fm) < WGM ? (nM - fm) : WGM;
        u.pm = fm + ((wgid % nig) % gsz); u.pn = (wgid % nig) / gsz; u.koff = 0; return true;
    }
};

template <int S, int KP>
struct SplitOrder {
    int pm0, nun, G, c;
    __device__ void init(int pm0_, int ntiles, int G_, int c_) { pm0 = pm0_; nun = ntiles * 4 * S; G = G_; c = c_; }
    __device__ bool next(int i, Unit& u) const {
        const int j = i * G + c; if (j >= nun) return false;
        const int tile = j / S, part = j % S; u.pm = pm0 + (tile >> 2); u.pn = part * 4 + (tile & 3); u.koff = part * KP * 2; return true;
    }
};
typedef f32x4 Acc[2][2][4][2];

struct EpiBf16 {
    static constexpr bool PERM = true, MIDHOOK = false;
    bf16_t* O; int ldc;
    __device__ __forceinline__ void mid(Acc& acc, const Unit& u, int t, int wr, int wc, int fr, int fq) const {}
    __device__ __forceinline__ void operator()(const Acc& acc, const Unit& u, int wr, int wc, int fr, int fq) const {
        const int row0 = u.pm * BM + wr * 64 + fr, col0 = u.pn * BM + wc * 32 + 8 * fq;
#pragma unroll
        for (int ai = 0; ai < 2; ++ai)
#pragma unroll
            for (int m = 0; m < 4; ++m) { bf16_t* rowp = O + (size_t)(row0 + ai * HALF + m * 16) * ldc + col0;
#pragma unroll
                for (int bj = 0; bj < 2; ++bj) { const f32x4 v0 = acc[ai][bj][m][0], v1 = acc[ai][bj][m][1];
                    u32x4 w; w.x = cvt_pk_bf16(v0[0], v0[1]); w.y = cvt_pk_bf16(v0[2], v0[3]); w.z = cvt_pk_bf16(v1[0], v1[1]); w.w = cvt_pk_bf16(v1[2], v1[3]);
                    *(u32x4*)(rowp + bj * HALF) = w; } }
    }
};
struct EpiMlaQ {
    static constexpr bool PERM = true, MIDHOOK = false;
    bf16_t* O; const float* rs;
    __device__ __forceinline__ void mid(Acc& acc, const Unit& u, int t, int wr, int wc, int fr, int fq) const {}
    __device__ __forceinline__ void operator()(const Acc& acc, const Unit& u, int wr, int wc, int fr, int fq) const {
        const int row0 = u.pm * BM + wr * 64 + fr, col0 = u.pn * BM + wc * 32 + 8 * fq;
        float rsv[2][4];
#pragma unroll
        for (int ai = 0; ai < 2; ++ai)
#pragma unroll
            for (int m = 0; m < 4; ++m) rsv[ai][m] = rs[2 * (row0 + ai * HALF + m * 16)];
#pragma unroll
        for (int ai = 0; ai < 2; ++ai)
#pragma unroll
            for (int m = 0; m < 4; ++m) { const int row = row0 + ai * HALF + m * 16; const float sc = rsv[ai][m];
                const int tk = row & (SEQ - 1); const bool lat = row < TLG;
                const float prow = lat ? (float)(tk >> 6) : 0.f, pcol = lat ? (float)(tk & 63) : 0.f;
#pragma unroll
                for (int bj = 0; bj < 2; ++bj) { const int c = col0 + bj * HALF; const int off = c % 96;
                    f32x4 v0 = acc[ai][bj][m][0] * sc, v1 = acc[ai][bj][m][1] * sc;
                    if (off >= 64) { const int ib = (off - 64) >> 1; const float pos = ib < 8 ? prow : pcol; const int jb = ib & 7;
                        const float f0 = __builtin_amdgcn_exp2f(-(float)(jb + 0) * (L2T / 8.f)), f1 = __builtin_amdgcn_exp2f(-(float)(jb + 1) * (L2T / 8.f));
                        const float f2 = __builtin_amdgcn_exp2f(-(float)(jb + 2) * (L2T / 8.f)), f3 = __builtin_amdgcn_exp2f(-(float)(jb + 3) * (L2T / 8.f));
                        float a0 = v0[0], a1 = v0[1], a2 = v0[2], a3 = v0[3], b0 = v1[0], b1 = v1[1], b2 = v1[2], b3 = v1[3];
                        rope_pair(a0, a1, pos * f0); rope_pair(a2, a3, pos * f1); rope_pair(b0, b1, pos * f2); rope_pair(b2, b3, pos * f3);
                        v0 = (f32x4){a0, a1, a2, a3}; v1 = (f32x4){b0, b1, b2, b3}; }
                    v0 = v0 * C2_96; v1 = v1 * C2_96;
                    u32x4 w; w.x = cvt_pk_bf16(v0[0], v0[1]); w.y = cvt_pk_bf16(v0[2], v0[3]); w.z = cvt_pk_bf16(v1[0], v1[1]); w.w = cvt_pk_bf16(v1[2], v1[3]);
                    *(u32x4*)(O + (size_t)row * 768 + c) = w; }
                asm volatile("" ::: "memory"); }
    }
};
struct EpiMlaKV {
    static constexpr bool PERM = true, MIDHOOK = false;
    bf16_t* KM; bf16_t* VM; const float* rs;
    __device__ __forceinline__ void mid(Acc& acc, const Unit& u, int t, int wr, int wc, int fr, int fq) const {}
    __device__ __forceinline__ void operator()(const Acc& acc, const Unit& u, int wr, int wc, int fr, int fq) const {
        const int row0 = u.pm * BM + wr * 64 + fr, col0 = u.pn * BM + wc * 32 + 8 * fq;
        float rsv[2][4];
#pragma unroll
        for (int ai = 0; ai < 2; ++ai)
#pragma unroll
            for (int m = 0; m < 4; ++m) rsv[ai][m] = rs[2 * (row0 + ai * HALF + m * 16)];
#pragma unroll
        for (int ai = 0; ai < 2; ++ai)
#pragma unroll
            for (int m = 0; m < 4; ++m) { const int row = row0 + ai * HALF + m * 16; const float sc = rsv[ai][m];
#pragma unroll
                for (int bj = 0; bj < 2; ++bj) { const int c = col0 + bj * HALF;
                    const f32x4 v0 = acc[ai][bj][m][0] * sc, v1 = acc[ai][bj][m][1] * sc;
                    u32x4 w; w.x = cvt_pk_bf16(v0[0], v0[1]); w.y = cvt_pk_bf16(v0[2], v0[3]); w.z = cvt_pk_bf16(v1[0], v1[1]); w.w = cvt_pk_bf16(v1[2], v1[3]);
                    bf16_t* dst = (c < 512) ? KM + (size_t)row * 768 + (c >> 6) * 96 + (c & 63) : VM + (size_t)row * 512 + (c - 512);
                    *(u32x4*)dst = w; }
                asm volatile("" ::: "memory"); }
    }
};
struct EpiGate {
    static constexpr bool PERM = true, MIDHOOK = true;
    const bf16_t* Z; const float* bg; bf16_t* Y;
    __device__ __forceinline__ void mid(Acc& acc, const Unit& u, int t, int wr, int wc, int fr, int fq) const {
        const int bc = (t >> 3) - 1;
        int row0 = u.pm * BM + wr * 64 + fr; const int col0 = u.pn * BM + wc * 32 + 8 * fq;
        asm volatile("" : "+v"(row0));
#pragma unroll
        for (int bj = 0; bj < 2; ++bj) { const float* b0 = bg + bc * 1024 + col0 + bj * HALF;
            const f32x4 bc0 = *(const f32x4*)b0, bc1 = *(const f32x4*)(b0 + 4), bn0 = *(const f32x4*)(b0 + 1024), bn1 = *(const f32x4*)(b0 + 1028);
#pragma unroll
            for (int ai = 0; ai < 2; ++ai) {
            u32x4 gc[4], gn[4];
#pragma unroll
                for (int m = 0; m < 4; ++m) { const unsigned zo = (unsigned)((row0 + ai * HALF + m * 16) * ZW + col0 + bj * HALF) * 2u;
                    const char* zb = (const char*)(Z + C_GT + bc * 1024);
                    gc[m] = *(const u32x4*)(zb + zo); gn[m] = *(const u32x4*)(zb + 2048 + zo); }
            asm volatile("" ::: "memory"); __builtin_amdgcn_sched_barrier(0);
#pragma unroll
                for (int m = 0; m < 4; ++m) { const u32x4 c = gc[m], n = gn[m];
                    const f32x4 xc0 = (f32x4){bf_lo(c.x), bf_hi(c.x), bf_lo(c.y), bf_hi(c.y)} + bc0, xc1 = (f32x4){bf_lo(c.z), bf_hi(c.z), bf_lo(c.w), bf_hi(c.w)} + bc1;
                    const f32x4 xn0 = (f32x4){bf_lo(n.x), bf_hi(n.x), bf_lo(n.y), bf_hi(n.y)} + bn0, xn1 = (f32x4){bf_lo(n.z), bf_hi(n.z), bf_lo(n.w), bf_hi(n.w)} + bn1;
                    f32x4 f0, f1;
#pragma unroll
                    for (int e = 0; e < 4; ++e) { f0[e] = (1.f + fast_exp(-xn0[e])) * __builtin_amdgcn_rcpf(1.f + fast_exp(-xc0[e])); f1[e] = (1.f + fast_exp(-xn1[e])) * __builtin_amdgcn_rcpf(1.f + fast_exp(-xc1[e])); }
                    acc[ai][bj][m][0] *= f0; acc[ai][bj][m][1] *= f1; }
            asm volatile("" ::: "memory"); } }
    }
    __device__ __forceinline__ void operator()(const Acc& acc, const Unit& u, int wr, int wc, int fr, int fq) const {
        const int row0 = u.pm * BM + wr * 64 + fr, col0 = u.pn * BM + wc * 32 + 8 * fq;
#pragma unroll
        for (int bj = 0; bj < 2; ++bj) { const float* b0 = bg + 2 * 1024 + col0 + bj * HALF;
            const f32x4 bb0 = *(const f32x4*)b0, bb1 = *(const f32x4*)(b0 + 4);
            u32x4 gq[2][4];
#pragma unroll
            for (int ai = 0; ai < 2; ++ai)
#pragma unroll
                for (int m = 0; m < 4; ++m) gq[ai][m] = *(const u32x4*)((const char*)(Z + C_GT + 2 * 1024) + (unsigned)((row0 + ai * HALF + m * 16) * ZW + col0 + bj * HALF) * 2u);
            asm volatile("" ::: "memory"); __builtin_amdgcn_sched_barrier(0);
#pragma unroll
            for (int ai = 0; ai < 2; ++ai) {
#pragma unroll
                for (int m = 0; m < 4; ++m) { const int row = row0 + ai * HALF + m * 16; const u32x4 gc = gq[ai][m];
                    const f32x4 x0 = (f32x4){bf_lo(gc.x), bf_hi(gc.x), bf_lo(gc.y), bf_hi(gc.y)} + bb0, x1 = (f32x4){bf_lo(gc.z), bf_hi(gc.z), bf_lo(gc.w), bf_hi(gc.w)} + bb1;
                    f32x4 v0 = acc[ai][bj][m][0], v1 = acc[ai][bj][m][1];
#pragma unroll
                    for (int e = 0; e < 4; ++e) { v0[e] *= sigmoidf(x0[e]); v1[e] *= sigmoidf(x1[e]); }
                    u32x4 w; w.x = cvt_pk_bf16(v0[0], v0[1]); w.y = cvt_pk_bf16(v0[2], v0[3]); w.z = cvt_pk_bf16(v1[0], v1[1]); w.w = cvt_pk_bf16(v1[2], v1[3]);
                    *(u32x4*)(Y + (size_t)row * 1024 + col0 + bj * HALF) = w; }
            asm volatile("" ::: "memory"); } }
    }
};
struct EpiResid {
    static constexpr bool PERM = false, MIDHOOK = false;
    float* XL; const float* XR; const float* mod; int g; int moff;
    __device__ __forceinline__ void mid(Acc& acc, const Unit& u, int t, int wr, int wc, int fr, int fq) const {}
    __device__ __forceinline__ void operator()(const Acc& acc, const Unit& u, int wr, int wc, int fr, int fq) const {
        const int col0 = u.pn * BM + wc * 32 + 4 * fq;
        const int r0 = u.pm * BM;
        float* xb = XL + (size_t)r0 * DM; const float* xr = XR + (size_t)r0 * DM; const float* mb = mod + (size_t)(g * GB + (r0 >> 11)) * NMOD + moff;
        f32x4 mv[2][2];
#pragma unroll
        for (int bj = 0; bj < 2; ++bj)
#pragma unroll
            for (int n = 0; n < 2; ++n) mv[bj][n] = *(const f32x4*)(mb + col0 + bj * HALF + n * 16);
#pragma unroll
        for (int ai = 0; ai < 2; ++ai) {
            f32x4 xv[4][2][2];
#pragma unroll
            for (int m = 0; m < 4; ++m)
#pragma unroll
                for (int bj = 0; bj < 2; ++bj)
#pragma unroll
                    for (int n = 0; n < 2; ++n) xv[m][bj][n] = *(const f32x4*)(xr + (unsigned)((ai * HALF + wr * 64 + m * 16 + fr) * DM + col0 + bj * HALF + n * 16));
            asm volatile("" ::: "memory"); __builtin_amdgcn_sched_barrier(0);
#pragma unroll
            for (int m = 0; m < 4; ++m)
#pragma unroll
                for (int bj = 0; bj < 2; ++bj)
#pragma unroll
                    for (int n = 0; n < 2; ++n) *(f32x4*)(xb + (unsigned)((ai * HALF + wr * 64 + m * 16 + fr) * DM + col0 + bj * HALF + n * 16)) = xv[m][bj][n] + mv[bj][n] * acc[ai][bj][m][n];
            asm volatile("" ::: "memory"); }
    }
};
struct EpiGateP {
    static constexpr bool PERM = true, MIDHOOK = false;
    const bf16_t* Z; const float* bg; float* PG;
    __device__ __forceinline__ void mid(Acc& acc, const Unit& u, int t, int wr, int wc, int fr, int fq) const {}
    __device__ __forceinline__ void operator()(const Acc& acc, const Unit& u, int wr, int wc, int fr, int fq) const {
        const int br = u.pn >> 2; const int row0 = u.pm * BM + wr * 64 + fr, col0 = (u.pn & 3) * BM + wc * 32 + 8 * fq;
        float* pb = PG + (size_t)br * TCG * DM;
#pragma unroll
        for (int bj = 0; bj < 2; ++bj) { const float* b0 = bg + br * 1024 + col0 + bj * HALF;
            const f32x4 bb0 = *(const f32x4*)b0, bb1 = *(const f32x4*)(b0 + 4);
#pragma unroll
            for (int ai = 0; ai < 2; ++ai) {
                u32x4 gq[4];
#pragma unroll
                for (int m = 0; m < 4; ++m) gq[m] = *(const u32x4*)(Z + (size_t)(row0 + ai * HALF + m * 16) * ZW + C_GT + br * 1024 + col0 + bj * HALF);
                asm volatile("" ::: "memory");
#pragma unroll
                for (int m = 0; m < 4; ++m) { const int row = row0 + ai * HALF + m * 16; const u32x4 gc = gq[m];
                    const f32x4 x0 = (f32x4){bf_lo(gc.x), bf_hi(gc.x), bf_lo(gc.y), bf_hi(gc.y)} + bb0, x1 = (f32x4){bf_lo(gc.z), bf_hi(gc.z), bf_lo(gc.w), bf_hi(gc.w)} + bb1;
                    f32x4 v0 = acc[ai][bj][m][0], v1 = acc[ai][bj][m][1];
#pragma unroll
                    for (int e = 0; e < 4; ++e) { v0[e] *= sigmoidf(x0[e]); v1[e] *= sigmoidf(x1[e]); }
                    float* dst = pb + (size_t)(row - TLG) * DM + col0 + bj * HALF; *(f32x4*)dst = v0; *(f32x4*)(dst + 4) = v1; }
                asm volatile("" ::: "memory"); } }
    }
};
struct EpiPartial {
    static constexpr bool PERM = false, MIDHOOK = false;
    float* P; const float* mod; int moff;
    __device__ __forceinline__ void mid(Acc& acc, const Unit& u, int t, int wr, int wc, int fr, int fq) const {}
    __device__ __forceinline__ void operator()(const Acc& acc, const Unit& u, int wr, int wc, int fr, int fq) const {
        float* pb = P + ((size_t)(u.pn >> 2) * TCG + (size_t)(u.pm * BM - TLG)) * DM; const float* mb = mod + (size_t)16 * NMOD + moff;
        const int col0 = (u.pn & 3) * BM + wc * 32 + 4 * fq;
#pragma unroll
        for (int bj = 0; bj < 2; ++bj)
#pragma unroll
            for (int n = 0; n < 2; ++n) { const int c = col0 + bj * HALF + n * 16; const f32x4 mv = *(const f32x4*)(mb + c);
#pragma unroll
                for (int ai = 0; ai < 2; ++ai)
#pragma unroll
                    for (int m = 0; m < 4; ++m) *(f32x4*)(pb + (unsigned)((ai * HALF + wr * 64 + m * 16 + fr) * DM + c)) = mv * acc[ai][bj][m][n]; }
    }
};
struct EpiSwiGLU {
    static constexpr bool PERM = true, MIDHOOK = false;
    bf16_t* H;
    __device__ __forceinline__ void mid(Acc& acc, const Unit& u, int t, int wr, int wc, int fr, int fq) const {}
    __device__ __forceinline__ void operator()(const Acc& acc, const Unit& u, int wr, int wc, int fr, int fq) const {
        const int row0 = u.pm * BM + wr * 64 + fr, col0 = u.pn * HALF + wc * 32 + 8 * fq;
#pragma unroll
        for (int ai = 0; ai < 2; ++ai)
#pragma unroll
            for (int m = 0; m < 4; ++m) { const int row = row0 + ai * HALF + m * 16;
                f32x4 v0, v1;
#pragma unroll
                for (int e = 0; e < 4; ++e) { const float g0 = acc[ai][0][m][0][e], g1 = acc[ai][0][m][1][e];
                    v0[e] = g0 * sigmoidf(g0) * acc[ai][1][m][0][e]; v1[e] = g1 * sigmoidf(g1) * acc[ai][1][m][1][e]; }
                u32x4 w; w.x = cvt_pk_bf16(v0[0], v0[1]); w.y = cvt_pk_bf16(v0[2], v0[3]); w.z = cvt_pk_bf16(v1[0], v1[1]); w.w = cvt_pk_bf16(v1[2], v1[3]);
                *(u32x4*)(H + (size_t)row * FH + col0) = w; }
    }
};

template <class Epi, class Sched, bool ALIGN_EPI, bool SP2>
__device__ __forceinline__ void gemm_phase(LAS unsigned char* lds, const Gemm g, const Sched& S, const Epi& E) {
    int tid_ = threadIdx.x; asm volatile("" : "+v"(tid_));
    const int tid = tid_, wid = __builtin_amdgcn_readfirstlane(tid >> 6), lane = tid & 63, wr = wid >> 2, wc = wid & 3, fr = lane & 15, fq = lane >> 4;
    const int K = g.K, nt = K / BK, lda = g.lda;
    unsigned voffA[2], voffB[2];
#pragma unroll
    for (int i = 0; i < 2; ++i) { int R, C; stage_rc(tid * 16 + i * 8192, R, C); const int Rb = Epi::PERM ? ((R & ~31) + perm32(R & 31)) : R;
        voffA[i] = (unsigned)(R * lda + C) * 2u; voffB[i] = (unsigned)(Rb * K + C) * 2u; }
    const size_t kstep = (size_t)(BK * 2);
    const size_t hstepA = (size_t)HALF * lda * 2, hstepB = (size_t)HALF * K * 2;
    const size_t tstepA = 2 * hstepA, tstepB = 2 * hstepB;
    const unsigned ldsw = (unsigned)wid * 1024u;
    const int aoff = lds_byte(wr * 64 + fr, fq * 8), boff = lds_byte(wc * 32 + fr, fq * 8);
#define PG8_SA(b, h) (((b) * 2 + (h)) * HTB)
#define PG8_SB(b, h) ((4 + (b) * 2 + (h)) * HTB)
#define PG8_STAGE(bufoff, gbase, voff) do { _Pragma("unroll") for (int _i = 0; _i < 2; ++_i) \
        __builtin_amdgcn_global_load_lds((const unsigned*)((const char*)(gbase) + (voff)[_i]), (LAS unsigned*)(lds + (bufoff) + ldsw + _i * 8192), 16, 0, 0); } while (0)
#define PG8_LDA(dst, b, h) do { _Pragma("unroll") for (int m = 0; m < 4; ++m) _Pragma("unroll") for (int k = 0; k < 2; ++k) dst[m][k] = *(const LAS bf16x8*)(lds + PG8_SA(b, h) + aoff + m * 2048 + k * 1024); } while (0)
#define PG8_LDB(dst, b, h) do { _Pragma("unroll") for (int n = 0; n < 2; ++n) _Pragma("unroll") for (int k = 0; k < 2; ++k) dst[n][k] = *(const LAS bf16x8*)(lds + PG8_SB(b, h) + boff + n * 2048 + k * 1024); } while (0)
#define PG8_MMA(ai, bj, At, Bt) do { __builtin_amdgcn_s_setprio(1); _Pragma("unroll") for (int m = 0; m < 4; ++m) _Pragma("unroll") for (int n = 0; n < 2; ++n) _Pragma("unroll") for (int k = 0; k < 2; ++k) \
        acc[ai][bj][m][n] = __builtin_amdgcn_mfma_f32_16x16x32_bf16(Bt[n][k], At[m][k], acc[ai][bj][m][n], 0, 0, 0); __builtin_amdgcn_s_setprio(0); } while (0)
#define PG8_WAIT_V(n) asm volatile("s_waitcnt vmcnt(" #n ")" ::: "memory")
#define PG8_WAIT_L(n) asm volatile("s_waitcnt lgkmcnt(" #n ")" ::: "memory")
#define PG8_BAR __builtin_amdgcn_s_barrier()
#define PG8_SCHED __builtin_amdgcn_sched_barrier(0)
    Unit cur, nxt; int ui = 0;
    if (!S.next(0, cur)) return;
    Acc acc;
#pragma unroll
    for (int a = 0; a < 2; ++a)
#pragma unroll
        for (int b = 0; b < 2; ++b)
#pragma unroll
            for (int m = 0; m < 4; ++m)
#pragma unroll
                for (int n = 0; n < 2; ++n) acc[a][b][m][n] = (f32x4){0.f, 0.f, 0.f, 0.f};
    bf16x8 At[4][2], B0[2][2], B1[2][2];
    const char* cA = (const char*)g.A + (size_t)cur.pm * tstepA + cur.koff; const char* cB = (const char*)g.Bt + (size_t)cur.pn * tstepB;
    static_assert(SP2, "only the SP2 loop is kept");
    PG8_STAGE(PG8_SB(0, 0), cB, voffB); PG8_STAGE(PG8_SB(0, 1), cB + hstepB, voffB); PG8_STAGE(PG8_SA(0, 0), cA, voffA); PG8_STAGE(PG8_SA(0, 1), cA + hstepA, voffA);
    if (wr == 1) PG8_BAR;
    PG8_WAIT_V(2); PG8_BAR;
    PG8_STAGE(PG8_SB(1, 0), cB + kstep, voffB); PG8_STAGE(PG8_SA(1, 0), cA + kstep, voffA); PG8_STAGE(PG8_SB(1, 1), cB + hstepB + kstep, voffB);
    PG8_WAIT_V(6); PG8_BAR;
    for (;;) {
        const bool has_next = S.next(ui + 1, nxt);
        const char* nA = has_next ? (const char*)g.A + (size_t)nxt.pm * tstepA + nxt.koff : cA; const char* nB = has_next ? (const char*)g.Bt + (size_t)nxt.pn * tstepB : cB;
#pragma nounroll
        for (int t = 0; t < nt; t += 2) {
            if constexpr (Epi::MIDHOOK) { if (t == 8 || t == 16) E.mid(acc, cur, t, wr, wc, fr, fq); }
            const bool last = (t == nt - 2);
            const char* a1 = cA + (size_t)(t + 1) * kstep;
            const char* a2 = last ? nA : cA + (size_t)(t + 2) * kstep; const char* b2 = last ? nB : cB + (size_t)(t + 2) * kstep;
            const char* a3 = a2 + kstep; const char* b3 = b2 + kstep;
            PG8_LDB(B0, 0, 0); PG8_LDB(B1, 0, 1); PG8_SCHED; PG8_LDA(At, 0, 0); PG8_STAGE(PG8_SA(1, 1), a1 + hstepA, voffA);
            PG8_WAIT_V(8); PG8_WAIT_L(0); PG8_BAR; PG8_MMA(0, 0, At, B0); PG8_MMA(0, 1, At, B1); PG8_BAR; PG8_SCHED;
            PG8_LDA(At, 0, 1); PG8_STAGE(PG8_SB(0, 0), b2, voffB); PG8_STAGE(PG8_SB(0, 1), b2 + hstepB, voffB); PG8_STAGE(PG8_SA(0, 0), a2, voffA);
            PG8_WAIT_V(8); PG8_WAIT_L(0); PG8_BAR; PG8_MMA(1, 0, At, B0); PG8_MMA(1, 1, At, B1); PG8_BAR; PG8_SCHED;
            PG8_LDB(B0, 1, 0); PG8_LDB(B1, 1, 1); PG8_SCHED; PG8_LDA(At, 1, 0); PG8_STAGE(PG8_SA(0, 1), a2 + hstepA, voffA);
            PG8_WAIT_V(8); PG8_WAIT_L(0); PG8_BAR; PG8_MMA(0, 0, At, B0); PG8_MMA(0, 1, At, B1); PG8_BAR; PG8_SCHED;
            PG8_LDA(At, 1, 1); PG8_STAGE(PG8_SB(1, 0), b3, voffB); PG8_STAGE(PG8_SB(1, 1), b3 + hstepB, voffB); PG8_STAGE(PG8_SA(1, 0), a3, voffA);
            PG8_WAIT_V(8); PG8_WAIT_L(0); PG8_BAR; PG8_MMA(1, 0, At, B0); PG8_MMA(1, 1, At, B1); PG8_BAR; PG8_SCHED;
        }
        if constexpr (ALIGN_EPI) { if (wr == 0) PG8_BAR; }
        E(acc, cur, wr, wc, fr, fq);
        if (!has_next) break;
#pragma unroll
        for (int a = 0; a < 2; ++a)
#pragma unroll
            for (int b = 0; b < 2; ++b)
#pragma unroll
                for (int m = 0; m < 4; ++m)
#pragma unroll
                    for (int n = 0; n < 2; ++n) acc[a][b][m][n] = (f32x4){0.f, 0.f, 0.f, 0.f};
        cur = nxt; cA = nA; cB = nB; ++ui;
        if constexpr (ALIGN_EPI) { if (wr == 1) PG8_BAR; }
    }
    PG8_WAIT_V(0);
    if constexpr (!ALIGN_EPI) { if (wr == 0) PG8_BAR; }
    PG8_BAR;
#undef PG8_SA
#undef PG8_SB
#undef PG8_STAGE
#undef PG8_LDA
#undef PG8_LDB
#undef PG8_MMA
#undef PG8_WAIT_V
#undef PG8_WAIT_L
#undef PG8_BAR
#undef PG8_SCHED
}
template <class Epi>
__device__ __forceinline__ void run_gemm(LAS unsigned char* lds, const bf16_t* A, int lda, const bf16_t* Bt, int M, int N, int K, const Epi& E) {
    Gemm g{A, Bt, lda, K}; StaticOrder S; S.init(M, N, NCU, (int)blockIdx.x);
    gemm_phase<Epi, StaticOrder, true, true>(lds, g, S, E);
}
template <int S_, int KP, class Epi>
__device__ __forceinline__ void run_gemm_split(LAS unsigned char* lds, const bf16_t* A, int lda, const bf16_t* Btp, int pm0, int ntiles, const Epi& E) {
    Gemm g{A, Btp, lda, KP}; SplitOrder<S_, KP> S; S.init(pm0, ntiles, NCU, (int)blockIdx.x);
    gemm_phase<Epi, SplitOrder<S_, KP>, true, true>(lds, g, S, E);
}
}

namespace att {
#define SBAR() __builtin_amdgcn_sched_barrier(0)
constexpr float THR = 8.f;
__device__ __forceinline__ int crow(int r, int hi) { return (r & 3) + 8 * (r >> 2) + 4 * hi; }
template <int DV> __device__ __forceinline__ int v_st(int k, int c) { const int kk = k; return ((kk >> 3) * (DV / 32) + (c >> 5)) * 512 + ((kk & 7) * 32 + (c & 31)) * 2; }
__device__ __forceinline__ int v_rd_base(int lane) { return ((lane & 3) << 3) | (((lane >> 2) & 3) << 6) | (((lane >> 4) & 1) << 5) | (((lane >> 5) & 1) << 8); }
template <int DV> constexpr int v_rd_off(int d0, int ks, int half) { return d0 * 512 + ks * (DV * 32) + half * (DV * 16); }
template <int OFF> __device__ __forceinline__ s16x4 tr_read(int vb) { s16x4 r; asm volatile("ds_read_b64_tr_b16 %0, %1 offset:%2" : "=&v"(r) : "v"(vb), "i"(OFF) : "memory"); return r; }

template <bool FIRST> __device__ __forceinline__ void partialSM(f32x16& p0, f32x16& p1, float& m_reg) {
    if constexpr (FIRST) {
        float pmax = p0[0];
#pragma unroll
        for (int r = 1; r < 16; ++r) pmax = fmaxf(pmax, p0[r]);
#pragma unroll
        for (int r = 0; r < 16; ++r) pmax = fmaxf(pmax, p1[r]);
        { auto rr = __builtin_amdgcn_permlane32_swap(__float_as_uint(pmax), __float_as_uint(pmax), false, false); pmax = fmaxf(__uint_as_float(rr[0]), __uint_as_float(rr[1])); }
        m_reg = bf_lo(cvt_pk_bf16(pmax, 0.f) & 0xffffu);
        const float mn = m_reg;
#pragma unroll
        for (int r = 0; r < 16; ++r) { p0[r] -= mn; p1[r] -= mn; }
    }
#pragma unroll
    for (int r = 0; r < 16; ++r) p0[r] = __builtin_amdgcn_exp2f(p0[r]);
}
__device__ __forceinline__ void finishSM(f32x16& p0, f32x16& p1, float& l_reg, bf16x8& pa0, bf16x8& pa1, bf16x8& pa2, bf16x8& pa3) {
#pragma unroll
    for (int r = 0; r < 16; ++r) p1[r] = __builtin_amdgcn_exp2f(p1[r]);
    float ps, psa = 0.f, psb = 0.f, psc = 0.f, psd = 0.f;
#pragma unroll
    for (int r = 0; r < 16; r += 4) { psa += p0[r]; psb += p0[r + 1]; psc += p0[r + 2]; psd += p0[r + 3]; }
#pragma unroll
    for (int r = 0; r < 16; r += 4) { psa += p1[r]; psb += p1[r + 1]; psc += p1[r + 2]; psd += p1[r + 3]; }
    ps = (psa + psb) + (psc + psd);
    { auto rr = __builtin_amdgcn_permlane32_swap(__float_as_uint(ps), __float_as_uint(ps), false, false); ps = __uint_as_float(rr[0]) + __uint_as_float(rr[1]); }
    l_reg += ps;
#define PK4(P, BASE, OUT) do { u32x4 w; w.x = cvt_pk_bf16(P[BASE + 0], P[BASE + 1]); w.y = cvt_pk_bf16(P[BASE + 2], P[BASE + 3]);   \
    w.z = cvt_pk_bf16(P[BASE + 4], P[BASE + 5]); w.w = cvt_pk_bf16(P[BASE + 6], P[BASE + 7]); OUT = __builtin_bit_cast(bf16x8, w); } while (0)
    PK4(p0, 0, pa0); PK4(p0, 8, pa1); PK4(p1, 0, pa2); PK4(p1, 8, pa3);
#undef PK4
}
template <int DK, bool BIAS> __device__ __forceinline__ void qkt(f32x16& p0, f32x16& p1, const LAS char* Ks, const bf16x8* qr, bf16x8 kone, bf16x8 qb, int r32, int hi) {
    constexpr int KS = DK * 2 + 16;
    p0 = f32x16{}; p1 = f32x16{};
#pragma unroll
    for (int d0 = 0; d0 < DK / 16; ++d0) {
        const bf16x8 b0 = *(const LAS bf16x8*)(Ks + r32 * KS + (2 * d0 + hi) * 16);
        const bf16x8 b1 = *(const LAS bf16x8*)(Ks + (32 + r32) * KS + (2 * d0 + hi) * 16);
        p0 = __builtin_amdgcn_mfma_f32_32x32x16_bf16(b0, qr[d0], p0, 0, 0, 0);
        p1 = __builtin_amdgcn_mfma_f32_32x32x16_bf16(b1, qr[d0], p1, 0, 0, 0); }
    if constexpr (BIAS) {
        p0 = __builtin_amdgcn_mfma_f32_32x32x16_bf16(kone, qb, p0, 0, 0, 0);
        p1 = __builtin_amdgcn_mfma_f32_32x32x16_bf16(kone, qb, p1, 0, 0, 0); }
}
struct VFr { s16x4 l0, h0, l1, h1, l2, h2, l3, h3; };
template <int DV, int D0> __device__ __forceinline__ void v_read(VFr& f, int vb) {
    f.l0 = tr_read<v_rd_off<DV>(D0, 0, 0)>(vb); f.h0 = tr_read<v_rd_off<DV>(D0, 0, 1)>(vb); f.l1 = tr_read<v_rd_off<DV>(D0, 1, 0)>(vb); f.h1 = tr_read<v_rd_off<DV>(D0, 1, 1)>(vb);
    f.l2 = tr_read<v_rd_off<DV>(D0, 2, 0)>(vb); f.h2 = tr_read<v_rd_off<DV>(D0, 2, 1)>(vb); f.l3 = tr_read<v_rd_off<DV>(D0, 3, 0)>(vb); f.h3 = tr_read<v_rd_off<DV>(D0, 3, 1)>(vb);
}
__device__ __forceinline__ void pv_mma(f32x16& od, const VFr& f, bf16x8 pa0, bf16x8 pa1, bf16x8 pa2, bf16x8 pa3) {
#define PK(L, H) (bf16x8){L[0], L[1], L[2], L[3], H[0], H[1], H[2], H[3]}
    od = __builtin_amdgcn_mfma_f32_32x32x16_bf16(pa0, PK(f.l0, f.h0), od, 0, 0, 0);
    od = __builtin_amdgcn_mfma_f32_32x32x16_bf16(pa1, PK(f.l1, f.h1), od, 0, 0, 0);
    od = __builtin_amdgcn_mfma_f32_32x32x16_bf16(pa2, PK(f.l2, f.h2), od, 0, 0, 0);
    od = __builtin_amdgcn_mfma_f32_32x32x16_bf16(pa3, PK(f.l3, f.h3), od, 0, 0, 0);
#undef PK
}
template <int DV> __device__ __forceinline__ void pv_all(f32x16* o, int vb, bf16x8 pa0, bf16x8 pa1, bf16x8 pa2, bf16x8 pa3) {
    VFr fa, fb;
    v_read<DV, 0>(fa, vb); v_read<DV, 1>(fb, vb);
    asm volatile("s_waitcnt lgkmcnt(8)" ::: "memory"); SBAR();
    pv_mma(o[0], fa, pa0, pa1, pa2, pa3);
    if constexpr (DV == 128) {
        SBAR(); v_read<DV, 2>(fa, vb);
        asm volatile("s_waitcnt lgkmcnt(8)" ::: "memory"); SBAR();
        pv_mma(o[1], fb, pa0, pa1, pa2, pa3);
        SBAR(); v_read<DV, 3>(fb, vb);
        asm volatile("s_waitcnt lgkmcnt(8)" ::: "memory"); SBAR();
        pv_mma(o[2], fa, pa0, pa1, pa2, pa3);
        asm volatile("s_waitcnt lgkmcnt(0)" ::: "memory"); SBAR();
        pv_mma(o[3], fb, pa0, pa1, pa2, pa3);
    } else {
        asm volatile("s_waitcnt lgkmcnt(0)" ::: "memory"); SBAR();
        pv_mma(o[1], fb, pa0, pa1, pa2, pa3);
    }
}
struct Stg { bf16x8 k0, k1, v0, v1; };
struct StgOff { unsigned k0, k1, v0, v1; };
template <int DK, int DV> __device__ __forceinline__ StgOff stg_offsets(int ldk, int ldv, int tid) {
    StgOff f; f.k0 = (unsigned)((tid >> 3) * ldk + (tid & 7) * 8) * 2u; f.k1 = (unsigned)((tid >> 2) * ldk + 64 + (tid & 3) * 8) * 2u;
    if constexpr (DV == 64) { f.v0 = (unsigned)((tid >> 3) * ldv + (tid & 7) * 8) * 2u; f.v1 = 0u; }
    else { f.v0 = (unsigned)((tid >> 4) * ldv + (tid & 15) * 8) * 2u; f.v1 = (unsigned)((32 + (tid >> 4)) * ldv + (tid & 15) * 8) * 2u; }
    return f;
}
template <int DK, int DV> __device__ __forceinline__ void sload(Stg& s, const bf16_t* Kt, const bf16_t* Vt, const StgOff& f, int tid) {
    s.k0 = *(const bf16x8*)((const char*)Kt + f.k0);
    if constexpr (DK == 96) { if (tid < 256) s.k1 = *(const bf16x8*)((const char*)Kt + f.k1); }
    s.v0 = *(const bf16x8*)((const char*)Vt + f.v0);
    if constexpr (DV == 128) s.v1 = *(const bf16x8*)((const char*)Vt + f.v1);
}
template <int DK, int DV> __device__ __forceinline__ void swrite(const Stg& s, LAS char* Kb, LAS char* Vb, int tid) {
    constexpr int KS = DK * 2 + 16;
    *(LAS bf16x8*)(Kb + (tid >> 3) * KS + (tid & 7) * 16) = s.k0;
    if constexpr (DK == 96) { if (tid < 256) *(LAS bf16x8*)(Kb + (tid >> 2) * KS + 128 + (tid & 3) * 16) = s.k1; }
    if constexpr (DV == 64) *(LAS bf16x8*)(Vb + v_st<DV>(tid >> 3, (tid & 7) * 8)) = s.v0;
    else { *(LAS bf16x8*)(Vb + v_st<DV>(tid >> 4, (tid & 15) * 8)) = s.v0; *(LAS bf16x8*)(Vb + v_st<DV>(32 + (tid >> 4), (tid & 15) * 8)) = s.v1; }
}
#define LBAR() asm volatile("s_waitcnt lgkmcnt(0)\n\ts_barrier" ::: "memory")
template <int DK, int DV, int MODE>
__device__ __forceinline__ void attn_unit(const bf16_t* __restrict__ Qb, int ldq, const bf16_t* __restrict__ Kc, const bf16_t* __restrict__ Kl, int ldk,
                                          const bf16_t* __restrict__ Vc, const bf16_t* __restrict__ Vl, int ldv, int NT,
                                          bf16_t* __restrict__ Ob, int ldo, float* scr, float lam, const float* gd, float osc, LAS char* lds) {
    constexpr int KS = DK * 2 + 16, KBYTES = 64 * KS, VBYTES = 64 * DV * 2, ND = DK / 16, NV = DV / 32;
    int tid_ = threadIdx.x; asm volatile("" : "+v"(tid_));
    const int tid = tid_, wid = tid >> 6, lane = tid & 63, r32 = lane & 31, hi = lane >> 5;
    LAS char* V_lds = lds; LAS char* K_lds = lds + 4 * VBYTES;
    LAS float* ws = (LAS float*)(lds + 4 * VBYTES + 4 * KBYTES) + wid * 64; LAS float* li_l = ws; LAS float* al_l = ws + 32;
    float m_reg = -1e30f, l_reg = 0.f; f32x16 o[NV]; bf16x8 qr[ND];
#pragma unroll
    for (int d = 0; d < NV; ++d) o[d] = f32x16{};
    const bf16_t* Qw = Qb + (size_t)(wid * 32 + r32) * ldq + hi * 8;
#pragma unroll
    for (int d0 = 0; d0 < ND; ++d0) qr[d0] = *(const bf16x8*)(Qw + d0 * 16);
    const int vb0 = (int)(unsigned)(uintptr_t)V_lds + v_rd_base(lane);
    Stg s0, s1; const StgOff sof = stg_offsets<DK, DV>(ldk, ldv, tid);
#define KT(t) (((t) < 4) ? Kc + (size_t)(t) * 64 * ldk : Kl + (size_t)((t) - 4) * 64 * ldk)
#define VT(t) (((t) < 4) ? Vc + (size_t)(t) * 64 * ldv : Vl + (size_t)((t) - 4) * 64 * ldv)
#define KB(t) (K_lds + ((t) & 3) * KBYTES)
#define VB(t) (V_lds + ((t) & 3) * VBYTES)
#define RESC(a) do { if (__any((a) < 1.f)) { if (hi == 0) al_l[r32] = (a); asm volatile("s_waitcnt lgkmcnt(0)" ::: "memory"); \
    _Pragma("unroll") for (int d = 0; d < NV; ++d) _Pragma("unroll") for (int r = 0; r < 16; ++r) o[d][r] *= al_l[crow(r, hi)]; } } while (0)
    f32x16 pA0, pA1, pB0, pB1; bf16x8 pa0, pa1, pa2, pa3;
    sload<DK, DV>(s0, KT(0), VT(0), sof, tid); sload<DK, DV>(s1, KT(1), VT(1), sof, tid);
    swrite<DK, DV>(s0, KB(0), VB(0), tid); swrite<DK, DV>(s1, KB(1), VB(1), tid);
    sload<DK, DV>(s0, KT(2), VT(2), sof, tid); sload<DK, DV>(s1, KT(3), VT(3), sof, tid);
    LBAR();
    bf16x8 kone = {0, 0, 0, 0, 0, 0, 0, 0}, qb = {0, 0, 0, 0, 0, 0, 0, 0};
    if (hi == 0) kone[0] = (short)0x3F80;
    qkt<DK, false>(pA0, pA1, KB(0), qr, kone, qb, r32, hi); partialSM<true>(pA0, pA1, m_reg);
    if (hi == 0) qb[0] = (short)(cvt_pk_bf16(-m_reg, 0.f) & 0xffffu);
    for (int j = 1; j + 1 < NT; j += 2) {
        LBAR();
        SBAR(); qkt<DK, true>(pB0, pB1, KB(j), qr, kone, qb, r32, hi);
        finishSM(pA0, pA1, l_reg, pa0, pa1, pa2, pa3); SBAR();
        swrite<DK, DV>(s0, KB(j + 1), VB(j + 1), tid);
        { const int tn = (j + 3 < NT) ? j + 3 : NT - 1; sload<DK, DV>(s0, KT(tn), VT(tn), sof, tid); }
        SBAR();
        pv_all<DV>(o, vb0 + ((j - 1) & 3) * VBYTES, pa0, pa1, pa2, pa3); partialSM<false>(pB0, pB1, m_reg);
        LBAR();
        SBAR(); qkt<DK, true>(pA0, pA1, KB(j + 1), qr, kone, qb, r32, hi);
        finishSM(pB0, pB1, l_reg, pa0, pa1, pa2, pa3); SBAR();
        swrite<DK, DV>(s1, KB(j + 2), VB(j + 2), tid);
        { const int tn = (j + 4 < NT) ? j + 4 : NT - 1; sload<DK, DV>(s1, KT(tn), VT(tn), sof, tid); }
        SBAR();
        pv_all<DV>(o, vb0 + (j & 3) * VBYTES, pa0, pa1, pa2, pa3); partialSM<false>(pA0, pA1, m_reg);
    }
    LBAR();
    SBAR(); qkt<DK, true>(pB0, pB1, KB(NT - 1), qr, kone, qb, r32, hi);
    finishSM(pA0, pA1, l_reg, pa0, pa1, pa2, pa3); SBAR();
    pv_all<DV>(o, vb0 + ((NT - 2) & 3) * VBYTES, pa0, pa1, pa2, pa3); partialSM<false>(pB0, pB1, m_reg);
    finishSM(pB0, pB1, l_reg, pa0, pa1, pa2, pa3); SBAR();
    pv_all<DV>(o, vb0 + ((NT - 1) & 3) * VBYTES, pa0, pa1, pa2, pa3);
    asm volatile("" ::: "memory");
    if (hi == 0) li_l[r32] = l_reg; asm volatile("s_waitcnt lgkmcnt(0)" ::: "memory");
    float rli[16];
#pragma unroll
    for (int r = 0; r < 16; ++r) rli[r] = __builtin_amdgcn_rcpf(li_l[crow(r, hi)]);
    if constexpr (MODE == 0) {
#pragma unroll
        for (int r = 0; r < 16; ++r) { bf16_t* op = Ob + (size_t)(wid * 32 + crow(r, hi)) * ldo + r32;
#pragma unroll
            for (int d0 = 0; d0 < NV; ++d0) op[d0 * 32] = (bf16_t)(cvt_pk_bf16(o[d0][r] * rli[r], 0.f) & 0xffffu); }
    } else if constexpr (MODE == 1) {
#pragma unroll
        for (int d0 = 0; d0 < NV; ++d0)
#pragma unroll
            for (int r4 = 0; r4 < 4; ++r4) ((f32x4*)scr)[(d0 * 4 + r4) * 512 + tid] = (f32x4){o[d0][4 * r4] * rli[4 * r4], o[d0][4 * r4 + 1] * rli[4 * r4 + 1], o[d0][4 * r4 + 2] * rli[4 * r4 + 2], o[d0][4 * r4 + 3] * rli[4 * r4 + 3]};
    } else {
        float gv[NV];
#pragma unroll
        for (int d0 = 0; d0 < NV; ++d0) gv[d0] = gd[d0 * 32 + r32] * osc;
#pragma unroll
        for (int r4 = 0; r4 < 4; ++r4) { f32x4 s4[NV];
#pragma unroll
            for (int d0 = 0; d0 < NV; ++d0) s4[d0] = ((const f32x4*)scr)[(d0 * 4 + r4) * 512 + tid];
#pragma unroll
          for (int rr = 0; rr < 4; ++rr) { const int r = 4 * r4 + rr; float od[NV]; float ss = 0.f;
#pragma unroll
            for (int d0 = 0; d0 < NV; ++d0) { od[d0] = s4[d0][rr] - lam * (o[d0][r] * rli[r]); ss += od[d0] * od[d0]; }
            ss = half32_sum(ss);
            const float rs = __builtin_amdgcn_rsqf(ss * (1.f / (float)DV) + EPS);
            bf16_t* op = Ob + (size_t)(wid * 32 + crow(r, hi)) * ldo + r32;
#pragma unroll
            for (int d0 = 0; d0 < NV; ++d0) op[d0 * 32] = (bf16_t)(cvt_pk_bf16(od[d0] * rs * gv[d0], 0.f) & 0xffffu); }
            asm volatile("" ::: "memory"); }
    }
    LBAR();
#undef KT
#undef VT
#undef KB
#undef VB
#undef RESC
}
#undef LBAR
#undef SBAR
}

struct Args { const float* in[28]; float* out; unsigned char* ws; };
enum { I_X = 0, I_C, I_CTX, I_CCTX, I_WMOD, I_BMOD, I_GN1, I_WIN, I_BGATE, I_LQ1, I_LK1, I_LQ2, I_LK2, I_GDIFF, I_GGQ, I_GGK, I_GMQ, I_WUQ, I_GMKV, I_WUKV,
       I_WBD, I_WBG, I_WBM, I_WOUT, I_GN2, I_WF1, I_WF2, I_GFIN };

__device__ __forceinline__ int map_row(int id, int n) {
    if (id == 1) { const int h = n / 96, off = n % 96; if (off < 64) return n; const int j = off - 64; const int i = (j & 7) + ((j >> 4) << 3), s = (j >> 3) & 1; return h * 96 + 64 + 2 * i + s; }
    if (id == 2) { const int h = n >> 7, j = n & 127; return j < 64 ? h * 64 + j : 512 + h * 64 + (j - 64); }
    if (id == 3) { const int isu = n >= FH ? 1 : 0; const int j = isu ? n - FH : n; return (j >> 7) * 256 + isu * 128 + (j & 127); }
    return n;
}
__device__ __forceinline__ void transpose_item(const float* W, int N, bf16_t* WT, int ld, int koff, int mapid, const float* kscale, LAS float* scr, int item, int lane) {
    const int nblk = N / 32, kb = item / nblk, nb = item % nblk, k0 = 64 * kb, n0 = 32 * nb;
    { float v[32];
#pragma unroll
      for (int i = 0; i < 32; ++i) { const int kk = 2 * i + (lane >> 5); v[i] = W[(size_t)(k0 + kk) * N + n0 + (lane & 31)]; }
#pragma unroll
      for (int i = 0; i < 32; ++i) { const int kk = 2 * i + (lane >> 5); float x = v[i]; if (kscale) x *= kscale[k0 + kk]; scr[kk * 33 + (lane & 31)] = x; } }
    asm volatile("s_waitcnt lgkmcnt(0)" ::: "memory");
    const int c = lane & 7;
#pragma unroll
    for (int j = 0; j < 4; ++j) { const int n = (lane >> 3) + 8 * j; const LAS float* s = scr + (8 * c) * 33 + n;
        u32x4 o; o.x = cvt_pk_bf16(s[0 * 33], s[1 * 33]); o.y = cvt_pk_bf16(s[2 * 33], s[3 * 33]); o.z = cvt_pk_bf16(s[4 * 33], s[5 * 33]); o.w = cvt_pk_bf16(s[6 * 33], s[7 * 33]);
        *(u32x4*)(WT + (size_t)map_row(mapid, n0 + n) * ld + koff + k0 + 8 * c) = o; }
    asm volatile("s_waitcnt lgkmcnt(0)" ::: "memory");
}

struct NRow { f32x4 v[4]; };
__device__ __forceinline__ void norm_load(NRow& r, const float* xrow, int lane) {
#pragma unroll
    for (int j = 0; j < 2; ++j) { r.v[2 * j] = *(const f32x4*)(xrow + 512 * j + 8 * lane); r.v[2 * j + 1] = *(const f32x4*)(xrow + 512 * j + 8 * lane + 4); }
}
template <int NP> __device__ __forceinline__ void norm_load_parts(NRow& r, const float* xrow, const float* prow, int lane) {
#pragma unroll
    for (int j = 0; j < 4; ++j) { const int c = 512 * (j >> 1) + 8 * lane + 4 * (j & 1); f32x4 v = *(const f32x4*)(xrow + c);
#pragma unroll
        for (int q = 0; q < NP; ++q) v += *(const f32x4*)(prow + (size_t)q * TCG * DM + c);
        r.v[j] = v; }
}
__device__ __forceinline__ void norm_finish(const NRow& r, float* cpy, const float* gn, const float* shift, const float* scale, bf16_t* orow, int lane) {
    float s = 0.f;
#pragma unroll
    for (int j = 0; j < 4; ++j) s += (r.v[j].x * r.v[j].x + r.v[j].y * r.v[j].y) + (r.v[j].z * r.v[j].z + r.v[j].w * r.v[j].w);
    if (cpy) {
#pragma unroll
        for (int j = 0; j < 4; ++j) *(f32x4*)(cpy + 512 * (j >> 1) + 8 * lane + 4 * (j & 1)) = r.v[j];
    }
    const float rs = __builtin_amdgcn_rsqf(wave_sum(s) * (1.f / DM) + EPS);
#pragma unroll
    for (int j = 0; j < 2; ++j) { const int c = 512 * j + 8 * lane;
        const f32x4 sh0 = *(const f32x4*)(shift + c), sh1 = *(const f32x4*)(shift + c + 4), gs0 = *(const f32x4*)(scale + c), gs1 = *(const f32x4*)(scale + c + 4);
        const f32x4 y0 = r.v[2 * j] * rs * gs0 + sh0, y1 = r.v[2 * j + 1] * rs * gs1 + sh1;
        u32x4 w; w.x = cvt_pk_bf16(y0.x, y0.y); w.y = cvt_pk_bf16(y0.z, y0.w); w.z = cvt_pk_bf16(y1.x, y1.y); w.w = cvt_pk_bf16(y1.z, y1.w); *(u32x4*)(orow + c) = w; }
}

struct PRow { u32x4 a, b, c, d; u32x2 m1, m2, qv; unsigned w0, w1, w2; };
__device__ __forceinline__ int post_base(int lane) { const int hd = lane >> 1; return (lane < 32) ? hd * 64 : C_GQ + (((hd - 16) < 10) ? (hd - 16) : 0) * 64; }
__device__ __forceinline__ void post_load(PRow& r, const bf16_t* zr, int lane) {
    const bf16_t* p1 = zr + post_base(lane) + 8 * (lane & 1);
    r.a = *(const u32x4*)p1; r.b = *(const u32x4*)(p1 + 16); r.c = *(const u32x4*)(p1 + 32); r.d = *(const u32x4*)(p1 + 48);
    const int q = lane & 3; const bf16_t* pm = zr + C_MKR + ((q < 2) ? 4 * q : 16 + 4 * (q - 2));
    r.m1 = *(const u32x2*)pm; r.m2 = *(const u32x2*)(pm + 8);
    const unsigned* pq = (const unsigned*)(zr + C_MCQ + lane * 6); r.w0 = pq[0]; r.w1 = pq[1]; r.w2 = pq[2];
    r.qv = *(const u32x2*)(zr + C_MCKV + lane * 4);
}
__device__ __forceinline__ void post_finish(PRow& r, bf16_t* zr, int row, float* rsq, float* rskv, bf16_t* kmr, const float* ggq, const float* ggk, int lane) {
    const bool lat = row < TLG; const int tk = row & (SEQ - 1);
    const float prow = lat ? (float)(tk >> 6) : 0.f, pcol = lat ? (float)(tk & 63) : 0.f;
    const int hf = lane & 1, hd = lane >> 1; const bool isg = lane >= 32; const int hg = hd - 16; const bool act = !isg || hg < 10;
    bf16_t* p1 = zr + post_base(lane) + 8 * hf;
    {
        float x1r[8] = {bf_lo(r.a.x), bf_hi(r.a.x), bf_lo(r.a.y), bf_hi(r.a.y), bf_lo(r.a.z), bf_hi(r.a.z), bf_lo(r.a.w), bf_hi(r.a.w)};
        float x2r[8] = {bf_lo(r.b.x), bf_hi(r.b.x), bf_lo(r.b.y), bf_hi(r.b.y), bf_lo(r.b.z), bf_hi(r.b.z), bf_lo(r.b.w), bf_hi(r.b.w)};
        float x1c[8] = {bf_lo(r.c.x), bf_hi(r.c.x), bf_lo(r.c.y), bf_hi(r.c.y), bf_lo(r.c.z), bf_hi(r.c.z), bf_lo(r.c.w), bf_hi(r.c.w)};
        float x2c[8] = {bf_lo(r.d.x), bf_hi(r.d.x), bf_lo(r.d.y), bf_hi(r.d.y), bf_lo(r.d.z), bf_hi(r.d.z), bf_lo(r.d.w), bf_hi(r.d.w)};
        float rs = 1.f;
        if (isg) {
            float ss = 0.f;
#pragma unroll
            for (int e = 0; e < 8; ++e) ss += (x1r[e] * x1r[e] + x2r[e] * x2r[e]) + (x1c[e] * x1c[e] + x2c[e] * x2c[e]);
            ss = xadd1(ss); rs = __builtin_amdgcn_rsqf(ss * (1.f / 64.f) + EPS);
            const float* gg = ((hg < 8) ? ggq : ggk) + 8 * hf;
#pragma unroll
            for (int e = 0; e < 8; ++e) { x1r[e] *= rs * gg[e]; x2r[e] *= rs * gg[16 + e]; x1c[e] *= rs * gg[32 + e]; x2c[e] *= rs * gg[48 + e]; }
        }
        const float sc = (isg ? hg < 8 : hd < 8) ? C2_64 : 1.f;
#pragma unroll
        for (int e = 0; e < 8; ++e) { const float f = __builtin_amdgcn_exp2f(-(float)(8 * hf + e) * (L2T / 16.f));
            rope_pair(x1r[e], x2r[e], prow * f); rope_pair(x1c[e], x2c[e], pcol * f);
            x1r[e] *= sc; x2r[e] *= sc; x1c[e] *= sc; x2c[e] *= sc; }
        u32x4 a, b, c, d;
        a.x = cvt_pk_bf16(x1r[0], x1r[1]); a.y = cvt_pk_bf16(x1r[2], x1r[3]); a.z = cvt_pk_bf16(x1r[4], x1r[5]); a.w = cvt_pk_bf16(x1r[6], x1r[7]);
        b.x = cvt_pk_bf16(x2r[0], x2r[1]); b.y = cvt_pk_bf16(x2r[2], x2r[3]); b.z = cvt_pk_bf16(x2r[4], x2r[5]); b.w = cvt_pk_bf16(x2r[6], x2r[7]);
        c.x = cvt_pk_bf16(x1c[0], x1c[1]); c.y = cvt_pk_bf16(x1c[2], x1c[3]); c.z = cvt_pk_bf16(x1c[4], x1c[5]); c.w = cvt_pk_bf16(x1c[6], x1c[7]);
        d.x = cvt_pk_bf16(x2c[0], x2c[1]); d.y = cvt_pk_bf16(x2c[2], x2c[3]); d.z = cvt_pk_bf16(x2c[4], x2c[5]); d.w = cvt_pk_bf16(x2c[6], x2c[7]);
        r.a = a; r.b = b; r.c = c; r.d = d;
    }
    const unsigned w0 = r.w0, w1 = r.w1, w2 = r.w2; const u32x2 qv = r.qv;
    float ssq = bf_lo(w0) * bf_lo(w0) + bf_hi(w0) * bf_hi(w0) + bf_lo(w1) * bf_lo(w1) + bf_hi(w1) * bf_hi(w1) + bf_lo(w2) * bf_lo(w2) + bf_hi(w2) * bf_hi(w2);
    ssq = wave_sum(ssq);
    float skv = bf_lo(qv.x) * bf_lo(qv.x) + bf_hi(qv.x) * bf_hi(qv.x) + bf_lo(qv.y) * bf_lo(qv.y) + bf_hi(qv.y) * bf_hi(qv.y);
    skv = wave_sum(skv);
    u32x4 mw;
    { const int q = lane & 3; const float pos = (q < 2) ? prow : pcol;
      float x1[4] = {bf_lo(r.m1.x), bf_hi(r.m1.x), bf_lo(r.m1.y), bf_hi(r.m1.y)}, x2[4] = {bf_lo(r.m2.x), bf_hi(r.m2.x), bf_lo(r.m2.y), bf_hi(r.m2.y)};
#pragma unroll
      for (int e = 0; e < 4; ++e) { const float f = __builtin_amdgcn_exp2f(-(float)(4 * (q & 1) + e) * (L2T / 8.f)); rope_pair(x1[e], x2[e], pos * f); }
      mw.x = cvt_pk_bf16(x1[0], x2[0]); mw.y = cvt_pk_bf16(x1[1], x2[1]); mw.z = cvt_pk_bf16(x1[2], x2[2]); mw.w = cvt_pk_bf16(x1[3], x2[3]); }
    if (act) { *(u32x4*)p1 = r.a; *(u32x4*)(p1 + 16) = r.b; *(u32x4*)(p1 + 32) = r.c; *(u32x4*)(p1 + 48) = r.d; }
    if (lane < 32) *(u32x4*)(kmr + (lane >> 2) * 96 + 64 + 8 * (lane & 3)) = mw;
    if (lane == 0) *(f32x2*)(rsq + 2 * row) = (f32x2){__builtin_amdgcn_rsqf(ssq * (1.f / 384.f) + EPS), __builtin_amdgcn_rsqf(skv * (1.f / 256.f) + EPS)};
}

#define XB_TMO      128
#define XB_XCNT(j)  (256  + 64 * (j))
#define XB_XSUB(j)  (1280 + 64 * (j))
#define XB_XGEN(j)  (2304 + 64 * (j))
#define XB_TOP      3328
#define XB_TOPGEN   3392
#define XCD_BAR_WORDS 3456
#define XB_SPIN_CAP (1u << 18)
__device__ __forceinline__ unsigned xb_ld(unsigned* p)              { return __hip_atomic_load(p, __ATOMIC_RELAXED, __HIP_MEMORY_SCOPE_AGENT); }
__device__ __forceinline__ unsigned xb_add(unsigned* p, unsigned v) { return __hip_atomic_fetch_add(p, v, __ATOMIC_RELAXED, __HIP_MEMORY_SCOPE_AGENT); }
__device__ __forceinline__ unsigned xb_xcc_id() { return (unsigned)__builtin_amdgcn_s_getreg((3 << 11) | 20) & 0xFu; }
#define XB_SPIN(cond, bar) do { unsigned _sp = 0; while (cond) { __builtin_amdgcn_s_sleep(1); \
    if ((++_sp & 255u) == 0u) { if (xb_ld(&(bar)[XB_TMO])) break; if (_sp > XB_SPIN_CAP) { atomicAdd(&(bar)[XB_TMO], 1u); break; } } } } while (0)
struct XcdBarrier { unsigned* bar; unsigned x; volatile LAS unsigned* st; };
__device__ __forceinline__ XcdBarrier xcd_barrier_post(unsigned* bar, volatile LAS unsigned* st) {
    XcdBarrier b; b.bar = bar; b.x = xb_xcc_id(); b.st = st;
    if (threadIdx.x == 0) (void)xb_add(&bar[XB_XCNT(b.x)], 1u);
    return b;
}
__device__ __forceinline__ void xcd_barrier_complete(unsigned* bar, unsigned x, unsigned& nloc, unsigned& nx) {
    const unsigned G = NCU;
    unsigned sum, cnt, mine, sp = 0u;
    for (;;) {
        sum = 0u; cnt = 0u; mine = 0u;
#pragma unroll
        for (unsigned j = 0; j < 16; ++j) { const unsigned c = xb_ld(&bar[XB_XCNT(j)]); sum += c; cnt += (c > 0u) ? 1u : 0u; mine = (j == x) ? c : mine; }
        if (sum == G) break;
        __builtin_amdgcn_s_sleep(1);
        if ((++sp & 255u) == 0u) { if (xb_ld(&bar[XB_TMO])) break; if (sp > XB_SPIN_CAP) { atomicAdd(&bar[XB_TMO], 1u); break; } }
    }
    nloc = mine > 0u ? mine : 1u; nx = cnt > 0u ? cnt : 1u;
}
__device__ __forceinline__ void xcd_barrier(unsigned* bar_, volatile LAS unsigned* st_) {
    XcdBarrier b; b.bar = bar_; b.st = st_;
    asm volatile("s_waitcnt vmcnt(0)" ::: "memory");
    __syncthreads();
    if (threadIdx.x == 0) {
        b.x = xb_xcc_id();
        unsigned* bar = b.bar;
        __builtin_amdgcn_s_waitcnt(0);
        unsigned nloc = b.st[0], nx = b.st[1];
        if (nloc == 0u) { xcd_barrier_complete(bar, b.x, nloc, nx); b.st[0] = nloc; b.st[1] = nx; }
        const unsigned old = xb_add(&bar[XB_XSUB(b.x)], 1u);
        const unsigned gen = old / nloc;
        if (old + 1u == (gen + 1u) * nloc) {
            __builtin_amdgcn_fence(__ATOMIC_RELEASE, "agent");
            asm volatile("s_waitcnt vmcnt(0)" ::: "memory");
            const unsigned og = xb_add(&bar[XB_TOP], 1u);
            const unsigned tg = og / nx;
            if (og + 1u == (tg + 1u) * nx) xb_add(&bar[XB_TOPGEN], 1u);
            else XB_SPIN(xb_ld(&bar[XB_TOPGEN]) == tg, bar);
            __builtin_amdgcn_fence(__ATOMIC_ACQUIRE, "agent");
            xb_add(&bar[XB_XGEN(b.x)], 1u);
            asm volatile("s_waitcnt vmcnt(0)" ::: "memory");
        } else {
            XB_SPIN(xb_ld(&bar[XB_XGEN(b.x)]) == gen, bar);
            __builtin_amdgcn_fence(__ATOMIC_ACQUIRE, "agent");
            asm volatile("s_waitcnt vmcnt(0)" ::: "memory");
        }
    }
    __syncthreads();
}

typedef __attribute__((address_space(4))) const Args* KArgs;
__device__ __forceinline__ void convert_layer(KArgs ap, unsigned char* ws, LAS float* scr, int cl, int w, int nw, int lane) {
    constexpr int N_IN = 16 * 189, N_UQ = 6 * 24, N_UKV = 4 * 32, N_BR = 8 * 32, N_OUT = 16 * 32, N_F1 = 16 * 176, N_F2 = 44 * 32;
    constexpr int N_L = N_IN + N_UQ + N_UKV + 3 * N_BR + N_OUT + N_F1 + N_F2;
    unsigned char* cw = ws + WS_W + (size_t)cl * WL_SZ;
    for (int it = w; it < N_L; it += nw) {
        int r = it;
        if (r < N_IN) { transpose_item(ap->in[I_WIN] + (size_t)cl * 1024 * INW, INW, (bf16_t*)(cw + WL_IN), 1024, 0, 0, nullptr, scr, r, lane); continue; } r -= N_IN;
        if (r < N_UQ) { transpose_item(ap->in[I_WUQ] + (size_t)cl * 384 * 768, 768, (bf16_t*)(cw + WL_UQ), 384, 0, 1, ap->in[I_GMQ] + cl * 384, scr, r, lane); continue; } r -= N_UQ;
        if (r < N_UKV) { transpose_item(ap->in[I_WUKV] + (size_t)cl * 256 * 1024, 1024, (bf16_t*)(cw + WL_UKV), 256, 0, 2, ap->in[I_GMKV] + cl * 256, scr, r, lane); continue; } r -= N_UKV;
        if (r < 3 * N_BR) { const int br = r / N_BR; const float* wb = (br == 0) ? ap->in[I_WBD] : (br == 1) ? ap->in[I_WBG] : ap->in[I_WBM];
            transpose_item(wb + (size_t)cl * 512 * 1024, 1024, (bf16_t*)(cw + WL_BR), 1536, br * 512, 0, nullptr, scr, r % N_BR, lane); continue; } r -= 3 * N_BR;
        if (r < N_OUT) { transpose_item(ap->in[I_WOUT] + (size_t)cl * 1024 * 1024, 1024, (bf16_t*)(cw + WL_OUT), 1024, 0, 0, nullptr, scr, r, lane); continue; } r -= N_OUT;
        if (r < N_F1) { transpose_item(ap->in[I_WF1] + (size_t)cl * 1024 * 2 * FH, 2 * FH, (bf16_t*)(cw + WL_F1), 1024, 0, 3, nullptr, scr, r, lane); continue; } r -= N_F1;
        transpose_item(ap->in[I_WF2] + (size_t)cl * FH * 1024, 1024, (bf16_t*)(cw + WL_F2), FH, 0, 0, nullptr, scr, r, lane);
    }
}
__device__ __forceinline__ void final_norm_row(float* xr, const float* gfin, int lane) {
    f32x4 v[4]; float s = 0.f;
#pragma unroll
    for (int j = 0; j < 4; ++j) { v[j] = *(const f32x4*)(xr + 256 * j + 4 * lane); s += (v[j].x * v[j].x + v[j].y * v[j].y) + (v[j].z * v[j].z + v[j].w * v[j].w); }
    const float rs = __builtin_amdgcn_rsqf(wave_sum(s) * (1.f / DM) + EPS);
#pragma unroll
    for (int j = 0; j < 4; ++j) { const f32x4 gf = *(const f32x4*)(gfin + 256 * j + 4 * lane); *(f32x4*)(xr + 256 * j + 4 * lane) = v[j] * rs * gf; }
}

#define PHASE_BEGIN() asm volatile("" : "+s"(g), "+s"(l)); unsigned lds_z = 0u; asm volatile("" : "+s"(lds_z)); LAS unsigned char* lds = lds_k + lds_z; int lane_t = (int)threadIdx.x; asm volatile("" : "+v"(lane_t)); const int lane = lane_t & 63; (void)lane; KArgs ap = (KArgs)__builtin_amdgcn_kernarg_segment_ptr(); asm volatile("" : "+s"(ap)); \
    unsigned char* ws = ap->ws; unsigned char* wl = ws + WS_W + (size_t)l * WL_SZ; (void)wl; \
    const float* modl = (const float*)(ws + WS_MOD) + (size_t)l * 17 * NMOD; (void)modl; \
    float* XL = ap->out + (size_t)g * TLG * DM; (void)XL; float* XCg = (float*)(ws + WS_XC) + (size_t)g * TCG * DM; (void)XCg; \
    bf16_t* XN = (bf16_t*)(ws + WS_XN); (void)XN; bf16_t* Z = (bf16_t*)(ws + WS_Z); (void)Z; bf16_t* O3 = (bf16_t*)(ws + WS_O3); (void)O3; \
    const int Mrows = (l == 0) ? TG : TLG; (void)Mrows;

__global__ void __launch_bounds__(512, 2) fwd_mega(Args args_unused) {
    extern __shared__ __attribute__((aligned(16))) unsigned char lds_raw[];
    cg::grid_group grid = cg::this_grid();
    LAS unsigned char* lds_k = (LAS unsigned char*)lds_raw;
    const int tid = threadIdx.x, wave = __builtin_amdgcn_readfirstlane(tid >> 6);
    constexpr int G = NCU; const int bx = blockIdx.x;
    __builtin_assume(bx >= 0 && bx < NCU);
    const int vcu = (G % 8 == 0) ? (bx % 8) * (G / 8) + bx / 8 : bx;
    const int gw = vcu * 8 + wave, NGW = G * 8;
    __builtin_assume(wave >= 0 && wave < 8); __builtin_assume(gw >= 0 && gw < NCU * 8);

    volatile LAS unsigned* bst = (volatile LAS unsigned*)(lds_k + 131072 + 512);
    if (tid < 2) bst[tid] = 0u;
    {
    int g = 0, l = 0; PHASE_BEGIN();
    if (bx == 0) { unsigned* bw = (unsigned*)ws; for (int i = tid; i < XCD_BAR_WORDS; i += 512) bw[i] = 0u; }
    if (bx < 192) {
        const int ml = bx / 96, ch = bx % 96;
        LAS float* S = (LAS float*)lds;
        LAS float* R = (LAS float*)(lds + 17 * 1024 * 4);
        const float* cin = ap->in[I_C]; const float* cctx = ap->in[I_CCTX];
        { float cv[34];
#pragma unroll
          for (int j = 0; j < 34; ++j) { const int i = tid + 512 * j, b = i >> 10, k = i & 1023; cv[j] = b < 16 ? cin[b * 1024 + k] : cctx[k]; }
#pragma unroll
          for (int j = 0; j < 34; ++j) S[tid + 512 * j] = cv[j] * sigmoidf(cv[j]); }
        __syncthreads();
        float acc[17];
#pragma unroll
        for (int b = 0; b < 17; ++b) acc[b] = 0.f;
        const float* wm = ap->in[I_WMOD] + (size_t)ml * 1024 * NMOD + ch * 64 + lane;
        for (int k0 = wave * 128; k0 < wave * 128 + 128; k0 += 16) {
            float w[16];
#pragma unroll
            for (int kk = 0; kk < 16; ++kk) w[kk] = wm[(size_t)(k0 + kk) * NMOD];
#pragma unroll
            for (int kk = 0; kk < 16; ++kk)
#pragma unroll
                for (int b = 0; b < 17; ++b) acc[b] += S[b * 1024 + k0 + kk] * w[kk]; }
#pragma unroll
        for (int b = 0; b < 17; ++b) R[(wave * 17 + b) * 64 + lane] = acc[b];
        __syncthreads();
        float* MOD = (float*)(ws + WS_MOD); const float* bmod = ap->in[I_BMOD];
        for (int i = tid; i < 17 * 64; i += 512) { const int b = i >> 6, ln = i & 63; float s = bmod[ml * NMOD + ch * 64 + ln];
#pragma unroll
            for (int w = 0; w < 8; ++w) s += R[(w * 17 + b) * 64 + ln];
            { const int col = ch * 64 + ln, mi = col >> 10, cc = col & 1023;
              if (mi == 1) s = ap->in[I_GN1][ml * DM + cc] * (1.f + s); else if (mi == 4) s = ap->in[I_GN2][ml * DM + cc] * (1.f + s); }
            MOD[((size_t)ml * 17 + b) * NMOD + ch * 64 + ln] = s; }
        __syncthreads();
    }
    {
        convert_layer(ap, ws, (LAS float*)(lds + wave * 16384), 0, gw, NGW, lane);
        for (int it = gw; it < 3 * 8 * 32; it += NGW) {
            const int br = it / 256; const float* wb = (br == 0) ? ap->in[I_WBD] : (br == 1) ? ap->in[I_WBG] : ap->in[I_WBM];
            transpose_item(wb, 1024, (bf16_t*)(ws + WS_WP6) + (size_t)br * 1024 * 512, 512, 0, 0, nullptr, (LAS float*)(lds + wave * 16384), it % 256, lane); }
        for (int it = gw; it < 16 * 32 + 44 * 32; it += NGW) {
            LAS float* scr = (LAS float*)(lds + wave * 16384);
            if (it < 16 * 32) { const int kb = it / 32, part = kb >> 2;
                transpose_item(ap->in[I_WOUT], 1024, (bf16_t*)(ws + WS_WP7) + (size_t)part * 1024 * 256, 256, -part * 256, 0, nullptr, scr, it, lane); }
            else { const int r2 = it - 16 * 32, kb = r2 / 32, part = kb / 22;
                transpose_item(ap->in[I_WF2], 1024, (bf16_t*)(ws + WS_WP10) + (size_t)part * 1024 * 1408, 1408, -part * 1408, 0, nullptr, scr, r2, lane); }
        }
        for (int i = bx * 512 + tid; i < 2 * 96 * 128; i += G * 512) { const int cl = i / (96 * 128), r = i % (96 * 128);
            *(u32x4*)(ws + WS_W + (size_t)cl * WL_SZ + WL_IN + ((size_t)INW * 1024 + (size_t)r * 8) * 2) = (u32x4){0u, 0u, 0u, 0u}; }
    }
    }
    grid.sync();
    { KArgs ap0 = (KArgs)__builtin_amdgcn_kernarg_segment_ptr(); (void)xcd_barrier_post((unsigned*)ap0->ws, bst); }
#define GRID_BAR() do { KArgs apb = (KArgs)__builtin_amdgcn_kernarg_segment_ptr(); asm volatile("" : "+s"(apb)); xcd_barrier((unsigned*)apb->ws, (volatile LAS unsigned*)(lds_k + 131072 + 512)); } while (0)

    for (int g = 0; g < NG; ++g) {
        for (int l = 0; l < DEPTH; ++l) {
            { PHASE_BEGIN();
              const float* xin = ap->in[I_X]; const float* cxin = ap->in[I_CTX]; const float* gn = ap->in[I_GN1] + l * DM;
#define A1_SRC(row, src, cpy, mp) const float* src; float* cpy = nullptr; const float* mp; { const bool lat = (row) < TLG; const int b = lat ? g * GB + ((row) >> 11) : 16; mp = modl + (size_t)b * NMOD; \
                if (lat) { if (l == 0) { src = xin + ((size_t)g * TLG + (row)) * DM; } else src = XL + (size_t)(row) * DM; } \
                else { const int rc = (row) - TLG; if (l == 0) { src = cxin + ((size_t)g * TCG + rc) * DM; cpy = XCg + (size_t)rc * DM; } else src = XCg + (size_t)rc * DM; } }
              for (int row = gw; row < TG; row += 3 * NGW) {
                const bool v1 = row + NGW < TG, v2 = row + 2 * NGW < TG; const int r1 = v1 ? row + NGW : row, r2 = v2 ? row + 2 * NGW : row;
                A1_SRC(row, s0, c0, m0) A1_SRC(r1, s1, c1, m1) A1_SRC(r2, s2, c2, m2)
                NRow n0, n1, n2;
                const float* P = (const float*)(ws + WS_QM);
                if (l == 1 && row >= TLG) { norm_load_parts<2>(n0, s0, P + (size_t)(row - TLG) * DM, lane); c0 = XCg + (size_t)(row - TLG) * DM; } else norm_load(n0, s0, lane);
                if (l == 1 && r1 >= TLG) { norm_load_parts<2>(n1, s1, P + (size_t)(r1 - TLG) * DM, lane); c1 = XCg + (size_t)(r1 - TLG) * DM; } else norm_load(n1, s1, lane);
                if (l == 1 && r2 >= TLG) { norm_load_parts<2>(n2, s2, P + (size_t)(r2 - TLG) * DM, lane); c2 = XCg + (size_t)(r2 - TLG) * DM; } else norm_load(n2, s2, lane);
                norm_finish(n0, c0, gn, m0, m0 + DM, XN + (size_t)row * DM, lane);
                if (v1) norm_finish(n1, c1, gn, m1, m1 + DM, XN + (size_t)r1 * DM, lane);
                if (v2) norm_finish(n2, c2, gn, m2, m2 + DM, XN + (size_t)r2 * DM, lane);
              } }
#undef A1_SRC
            GRID_BAR();
#ifndef X_NO_A2
            { PHASE_BEGIN(); pg8::EpiBf16 E{Z, ZW}; pg8::run_gemm(lds, XN, DM, (const bf16_t*)(wl + WL_IN), TG, ZW, DM, E); }
#endif
            GRID_BAR();
            { PHASE_BEGIN();
              float* RSQ = (float*)(ws + WS_RS); float* RSKV = RSQ + TG; bf16_t* KM = (bf16_t*)(ws + WS_KM);
              const float* ggq = ap->in[I_GGQ] + l * 64; const float* ggk = ap->in[I_GGK] + l * 64;
              for (int row = gw; row < TG; row += 3 * NGW) {
                const bool v1 = row + NGW < TG, v2 = row + 2 * NGW < TG; const int r1 = v1 ? row + NGW : row, r2 = v2 ? row + 2 * NGW : row;
                PRow p0, p1, p2; post_load(p0, Z + (size_t)row * ZW, lane); post_load(p1, Z + (size_t)r1 * ZW, lane); post_load(p2, Z + (size_t)r2 * ZW, lane);
                asm volatile("" ::: "memory");
                post_finish(p0, Z + (size_t)row * ZW, row, RSQ, RSKV, KM + (size_t)row * 768, ggq, ggk, lane);
                if (v1) post_finish(p1, Z + (size_t)r1 * ZW, r1, RSQ, RSKV, KM + (size_t)r1 * 768, ggq, ggk, lane);
                if (v2) post_finish(p2, Z + (size_t)r2 * ZW, r2, RSQ, RSKV, KM + (size_t)r2 * 768, ggq, ggk, lane);
              } }
            GRID_BAR();
#ifndef X_NO_A4
            { PHASE_BEGIN(); float* RSQ = (float*)(ws + WS_RS); pg8::EpiMlaQ E{(bf16_t*)(ws + WS_QM), RSQ}; pg8::run_gemm(lds, Z + C_MCQ, ZW, (const bf16_t*)(wl + WL_UQ), TG, 768, 384, E); }
            { PHASE_BEGIN(); float* RSKV = (float*)(ws + WS_RS) + 1; pg8::EpiMlaKV E{(bf16_t*)(ws + WS_KM), (bf16_t*)(ws + WS_VM), RSKV}; pg8::run_gemm(lds, Z + C_MCKV, ZW, (const bf16_t*)(wl + WL_UKV), TG, 1024, 256, E); }
#endif
            GRID_BAR();
#ifndef X_NO_A5
            { PHASE_BEGIN();
                const float lam_init = (l == 0) ? 0.2f : 0.35550906759096934f;
                float lam;
                { float a = ap->in[I_LQ1][l * 64 + lane] * ap->in[I_LK1][l * 64 + lane], b = ap->in[I_LQ2][l * 64 + lane] * ap->in[I_LK2][l * 64 + lane];
                  a = wave_sum(a); b = wave_sum(b); lam = fast_exp(a) - fast_exp(b) + lam_init; }
                const float* gd = ap->in[I_GDIFF] + l * 128; const float osc = 1.f - lam_init;
                const int nunits = (l == 0) ? 1440 : 1280;
                LAS char* al = (LAS char*)lds;
                float* SCR = (float*)(ws + WS_SCR) + (size_t)bx * 32768;
                const bf16_t* QM = (const bf16_t*)(ws + WS_QM); const bf16_t* KM = (const bf16_t*)(ws + WS_KM); const bf16_t* VM = (const bf16_t*)(ws + WS_VM);
                for (int i = 0;; ++i) {
                    const int idx = i * 256 + vcu; if (idx >= nunits) break;
                    int type, bl, h, qrow, NT;
                    if (idx < 1280) { NT = 36;
                        if (idx < 256) { type = 0; bl = idx >> 5; h = (idx >> 3) & 3; qrow = bl * SEQ + (idx & 7) * 256; }
                        else if (idx < 768) { const int j = idx - 256; type = 1; bl = j >> 6; h = (j >> 3) & 7; qrow = bl * SEQ + (j & 7) * 256; }
                        else { const int j = idx - 768; type = 2; bl = j >> 6; h = (j >> 3) & 7; qrow = bl * SEQ + (j & 7) * 256; }
                    } else { const int j = idx - 1280; NT = 4;
                        if (j < 32) { type = 0; bl = j >> 2; h = j & 3; } else if (j < 96) { type = 1; bl = (j - 32) >> 3; h = (j - 32) & 7; } else { type = 2; bl = (j - 96) >> 3; h = (j - 96) & 7; }
                        qrow = TLG + bl * CTXL; }
                    const size_t cr = (size_t)(TLG + bl * CTXL), lr = (size_t)bl * SEQ;
                    if (type == 0) {
#ifndef X_NO_T0
                        const bf16_t* q = Z + (size_t)qrow * ZW + C_DQ + h * 128; const bf16_t* kc = Z + cr * ZW + C_DK + h * 128; const bf16_t* kl = Z + lr * ZW + C_DK + h * 128;
                        const bf16_t* vc = Z + cr * ZW + C_DV + h * 128; const bf16_t* vl = Z + lr * ZW + C_DV + h * 128;
                        bf16_t* ob = O3 + (size_t)qrow * 1536 + h * 128;
                        att::attn_unit<64, 128, 1>(q, ZW, kc, kl, ZW, vc, vl, ZW, NT, ob, 1536, SCR, lam, gd, osc, al);
                        att::attn_unit<64, 128, 2>(q + 64, ZW, kc + 64, kl + 64, ZW, vc, vl, ZW, NT, ob, 1536, SCR, lam, gd, osc, al);
#endif
                    } else if (type == 1) {
#ifndef X_NO_T1
                        const int hk = h >> 2;
                        att::attn_unit<64, 64, 0>(Z + (size_t)qrow * ZW + C_GQ + h * 64, ZW, Z + cr * ZW + C_GK + hk * 64, Z + lr * ZW + C_GK + hk * 64, ZW,
                                                  Z + cr * ZW + C_GV + hk * 64, Z + lr * ZW + C_GV + hk * 64, ZW, NT, O3 + (size_t)qrow * 1536 + 512 + h * 64, 1536, SCR, lam, gd, osc, al);
#endif
                    } else {
#ifndef X_NO_T2
                        att::attn_unit<96, 64, 0>(QM + (size_t)qrow * 768 + h * 96, 768, KM + cr * 768 + h * 96, KM + lr * 768 + h * 96, 768,
                                                  VM + cr * 512 + h * 64, VM + lr * 512 + h * 64, 512, NT, O3 + (size_t)qrow * 1536 + 1024 + h * 64, 1536, SCR, lam, gd, osc, al);
#endif
                    }
                }
            }
#endif
            GRID_BAR();
#ifndef X_NO_A6
            { PHASE_BEGIN(); pg8::EpiGate E{Z, ap->in[I_BGATE] + l * 3072, XN}; pg8::run_gemm(lds, O3, 1536, (const bf16_t*)(wl + WL_BR), TLG, 1024, 1536, E); }
            if (l == 0) { PHASE_BEGIN(); pg8::EpiGateP E{Z, ap->in[I_BGATE], (float*)(ws + WS_QM + 32 * MiB)}; pg8::run_gemm_split<3, 512>(lds, O3, 1536, (const bf16_t*)(ws + WS_WP6), TLG / 256, TCG / 256, E); }
#endif
            GRID_BAR();
#ifndef X_NO_A7
            if (l == 0) { PHASE_BEGIN();
                const float* PG = (const float*)(ws + WS_QM + 32 * MiB);
                for (int row = gw; row < TCG; row += NGW) {
#pragma unroll
                    for (int j = 0; j < 4; ++j) { const size_t o = (size_t)row * DM + 256 * j + 4 * lane;
                        const f32x4 y = *(const f32x4*)(PG + o) + *(const f32x4*)(PG + (size_t)TCG * DM + o) + *(const f32x4*)(PG + (size_t)2 * TCG * DM + o);
                        u32x2 w; w.x = cvt_pk_bf16(y.x, y.y); w.y = cvt_pk_bf16(y.z, y.w); *(u32x2*)(XN + (size_t)TLG * DM + o) = w; } } }
            { PHASE_BEGIN(); const float* xrd = (l == 0) ? ap->in[I_X] + (size_t)g * TLG * DM : XL;
              pg8::EpiResid E{XL, xrd, modl, g, 2 * DM}; pg8::run_gemm(lds, XN, DM, (const bf16_t*)(wl + WL_OUT), TLG, 1024, 1024, E); }
            if (l == 0) GRID_BAR();
            if (l == 0) { PHASE_BEGIN(); pg8::EpiPartial E{(float*)(ws + WS_QM), modl, 2 * DM}; pg8::run_gemm_split<4, 256>(lds, XN, DM, (const bf16_t*)(ws + WS_WP7), TLG / 256, TCG / 256, E); }
#endif
            GRID_BAR();
            { PHASE_BEGIN();
              const float* gn = ap->in[I_GN2] + l * DM;
              for (int row = gw; row < Mrows; row += 2 * NGW) {
                const int r1 = row + NGW; const bool v1 = r1 < Mrows; const int r1c = v1 ? r1 : row;
                const bool lat0 = row < TLG, lat1 = r1c < TLG;
                const float* mp0 = modl + (size_t)(lat0 ? g * GB + (row >> 11) : 16) * NMOD; const float* mp1 = modl + (size_t)(lat1 ? g * GB + (r1c >> 11) : 16) * NMOD;
                const float* s0 = lat0 ? XL + (size_t)row * DM : XCg + (size_t)(row - TLG) * DM; const float* s1 = lat1 ? XL + (size_t)r1c * DM : XCg + (size_t)(r1c - TLG) * DM;
                NRow n0, n1; float* c0 = nullptr; float* c1 = nullptr;
                if (!lat0) { const float* P = (const float*)(ws + WS_QM);
                    norm_load_parts<4>(n0, s0, P + (size_t)(row - TLG) * DM, lane); c0 = XCg + (size_t)(row - TLG) * DM; } else norm_load(n0, s0, lane);
                if (!lat1) { const float* P = (const float*)(ws + WS_QM);
                    norm_load_parts<4>(n1, s1, P + (size_t)(r1c - TLG) * DM, lane); c1 = XCg + (size_t)(r1c - TLG) * DM; } else norm_load(n1, s1, lane);
                norm_finish(n0, c0, gn, mp0 + 3 * DM, mp0 + 4 * DM, XN + (size_t)row * DM, lane);
                if (v1) norm_finish(n1, c1, gn, mp1 + 3 * DM, mp1 + 4 * DM, XN + (size_t)r1 * DM, lane);
              } }
            GRID_BAR();
#ifndef X_NO_A9
            { PHASE_BEGIN(); pg8::EpiSwiGLU E{Z}; pg8::run_gemm(lds, XN, DM, (const bf16_t*)(wl + WL_F1), Mrows, 2 * FH, DM, E); }
#endif
            GRID_BAR();
#ifndef X_NO_A10
            { PHASE_BEGIN(); pg8::EpiResid E{XL, XL, modl, g, 5 * DM}; pg8::run_gemm(lds, Z, FH, (const bf16_t*)(wl + WL_F2), TLG, 1024, FH, E); }
            if (l == 0) { PHASE_BEGIN(); pg8::EpiPartial E{(float*)(ws + WS_QM), modl, 5 * DM}; pg8::run_gemm_split<2, 1408>(lds, Z, FH, (const bf16_t*)(ws + WS_WP10), TLG / 256, TCG / 256, E); }
            if (l == 0 && bx >= 64) { PHASE_BEGIN();
                const int w = (bx - 64) * 8 + wave, nw = (NCU - 64) * 8;
                if (g == 0) convert_layer(ap, ws, (LAS float*)(lds + wave * 16384), 1, w, nw, lane);
                else { const float* gfin = ap->in[I_GFIN]; float* outp = ap->out; for (int row = w; row < TLG; row += nw) final_norm_row(outp + (size_t)row * DM, gfin, lane); }
            }
#endif
            GRID_BAR();
        }
    }
    static_assert(NG == 2, "the side-job split of the final norm assumes two groups");
    { int g = 0, l = 0; PHASE_BEGIN();
      const float* gfin = ap->in[I_GFIN]; float* outp = ap->out;
      for (int row = TLG + gw; row < NB * SEQ; row += NGW) final_norm_row(outp + (size_t)row * DM, gfin, lane); }
}

extern "C" void kernel_launch(void* const* d_in, const int* in_sizes, int n_in, void* d_out, int out_size, void* d_ws, size_t ws_size, hipStream_t stream) {
    static int grid = 0;
    if (grid == 0) {
        if (n_in != 28 || out_size != NB * SEQ * DM || ws_size < WS_END) { fprintf(stderr, "kernel_launch: unexpected shapes (n_in %d out %d ws %zu need %zu)\n", n_in, out_size, ws_size, (size_t)WS_END); grid = -1; return; }
        int dev = 0, cus = 0, per_cu = 0;
        (void)hipGetDevice(&dev);
        (void)hipDeviceGetAttribute(&cus, hipDeviceAttributeMultiprocessorCount, dev);
        (void)hipFuncSetAttribute((const void*)fwd_mega, hipFuncAttributeMaxDynamicSharedMemorySize, LDS_BYTES);
        (void)hipOccupancyMaxActiveBlocksPerMultiprocessor(&per_cu, (const void*)fwd_mega, 512, LDS_BYTES);
        if (per_cu < 1) { fprintf(stderr, "kernel_launch: occupancy query says %d blocks/CU\n", per_cu); per_cu = 1; }
        grid = NCU;
        if (cus * per_cu < NCU) fprintf(stderr, "kernel_launch: device holds %d x %d workgroups, the kernel needs %d co-resident\n", cus, per_cu, NCU);
        fprintf(stderr, "kernel_launch: grid %d (cus %d, per_cu %d)\n", grid, cus, per_cu);
    }
    if (grid < 0) return;
    Args a{};
    for (int i = 0; i < 28; ++i) a.in[i] = (const float*)d_in[i];
    a.out = (float*)d_out; a.ws = (unsigned char*)d_ws;
    void* kargs[] = {&a};
    hipError_t e = hipLaunchCooperativeKernel((const void*)fwd_mega, dim3(grid), dim3(512), kargs, LDS_BYTES, stream);
    if (e != hipSuccess) fprintf(stderr, "kernel_launch: cooperative launch failed: %s (grid %d)\n", hipGetErrorString(e), grid);
}
```
